# Optimizing an MI355X kernel written in HIP

```python
import jax
import jax.numpy as jnp
from jax import lax
import numpy as np


D_MODEL = 2048
BATCH = 4
SEQ = 8192
DEPTH = 4
DEC_BATCH = 2
DEC_SEQ = 8192
PAST_LEN = 128

GRID_W = 64
CHUNK = 128
Q_BLOCK = 128
CONV_WIDTH = 3
D_CONV = D_MODEL // 2
D_SGU = D_MODEL // 2
SGU_GROUPS = 8
SGU_GROUP_DIM = D_SGU // SGU_GROUPS
HEAD_DIM = 128
N_Q_HEADS = D_MODEL // HEAD_DIM
N_KV_HEADS = N_Q_HEADS // 4
GQA_GROUP = N_Q_HEADS // N_KV_HEADS
D_ATTN = N_Q_HEADS * HEAD_DIM
D_KV = N_KV_HEADS * HEAD_DIM
N_BRANCH = 3
ROPE_THETA = 10000.0
ROPE_AXIS_DIM = HEAD_DIM // 2
D_FF = -(-8 * D_MODEL // (3 * 256)) * 256
SPLIT_SIZES = (D_CONV, D_CONV, D_CONV, D_SGU, D_SGU, D_ATTN, D_KV, D_KV, N_BRANCH * D_MODEL)
D_IN = 3 * D_CONV + 2 * D_SGU + D_ATTN + 2 * D_KV + N_BRANCH * D_MODEL
EPS = 1e-6

kernel_name = 'hybrid_gated_conv_sgu_axial_gqa_encoder'


def rms_norm(x, g):
    xf = x.astype(jnp.float32)
    y = xf * lax.rsqrt(jnp.mean(xf * xf, axis=-1, keepdims=True) + EPS)
    return (y * g.astype(jnp.float32)).astype(x.dtype)


def layer_norm(x, g):
    xf = x.astype(jnp.float32)
    xc = xf - jnp.mean(xf, axis=-1, keepdims=True)
    y = xc * lax.rsqrt(jnp.mean(xc * xc, axis=-1, keepdims=True) + EPS)
    return (y * g.astype(jnp.float32)).astype(x.dtype)


def split_columns(z):
    parts = []
    start = 0
    for size in SPLIT_SIZES:
        parts.append(z[..., start:start + size])
        start += size
    return parts


def short_conv_mixer(b_gate, c_gate, x_in, conv_w):
    h = c_gate * x_in
    s = h.shape[1]
    pad = CONV_WIDTH // 2
    hp = jnp.pad(h, ((0, 0), (pad, pad), (0, 0)))
    y = hp[:, 0:s] * conv_w[0]
    for j in range(1, CONV_WIDTH):
        y = y + hp[:, j:j + s] * conv_w[j]
    return b_gate * y


def spatial_gating(u, v, ln_g, w_s, b_s):
    bsz, s, _ = v.shape
    vn = layer_norm(v, ln_g).reshape(bsz, s // CHUNK, CHUNK, SGU_GROUPS, SGU_GROUP_DIM)
    mixed = jnp.einsum('gpq,bnqgc->bnpgc', w_s, vn) + b_s.T[None, None, :, :, None]
    return u * mixed.reshape(bsz, s, D_SGU)


def axial_rope_tables(seq_len):
    rows = seq_len // GRID_W
    row_idx = jnp.repeat(jnp.arange(rows, dtype=jnp.float32), GRID_W)
    col_idx = jnp.tile(jnp.arange(GRID_W, dtype=jnp.float32), rows)
    inv_freq = 1.0 / (ROPE_THETA ** (jnp.arange(0, ROPE_AXIS_DIM, 2, dtype=jnp.float32) / ROPE_AXIS_DIM))
    ang_row = row_idx[:, None] * inv_freq[None, :]
    ang_col = col_idx[:, None] * inv_freq[None, :]
    return (jnp.cos(ang_row), jnp.sin(ang_row), jnp.cos(ang_col), jnp.sin(ang_col))


def rotate_half_block(x, cos, sin):
    x1, x2 = jnp.split(x, 2, axis=-1)
    c = cos[None, :, None, :]
    sn = sin[None, :, None, :]
    return jnp.concatenate([x1 * c - x2 * sn, x2 * c + x1 * sn], axis=-1)


def apply_axial_rope(x, tables):
    cos_r, sin_r, cos_c, sin_c = tables
    xf = x.astype(jnp.float32)
    out = jnp.concatenate([rotate_half_block(xf[..., :ROPE_AXIS_DIM], cos_r, sin_r),
                           rotate_half_block(xf[..., ROPE_AXIS_DIM:], cos_c, sin_c)], axis=-1)
    return out.astype(x.dtype)


def gqa_attention(q, k, v):
    bsz, s = q.shape[0], q.shape[1]
    nb = s // Q_BLOCK
    scale = HEAD_DIM ** -0.5
    qb = (q * scale).reshape(bsz, nb, Q_BLOCK, N_KV_HEADS, GQA_GROUP, HEAD_DIM).transpose(1, 0, 2, 3, 4, 5)

    def one_block(qi):
        scores = jnp.einsum('bqhgd,bkhd->bhgqk', qi, k).astype(jnp.float32)
        p = jax.nn.softmax(scores, axis=-1).astype(v.dtype)
        return jnp.einsum('bhgqk,bkhd->bqhgd', p, v)

    out = lax.map(one_block, qb)
    return out.transpose(1, 0, 2, 3, 4, 5).reshape(bsz, s, D_ATTN)


def swiglu(h, w_in, w_out):
    gate, up = jnp.split(h @ w_in, 2, axis=-1)
    return (jax.nn.silu(gate) * up) @ w_out


def encoder_layer(x, tables, norm_mix, w_in, gate_bias, conv_w, sgu_ln, sgu_ws, sgu_b, q_norm, k_norm,
                  w_br_conv, w_br_sgu, w_br_attn, w_out, norm_ffn, w_ffn_in, w_ffn_out):
    bsz, s, _ = x.shape
    h = rms_norm(x, norm_mix)
    cb, cc, cx, su, sv, q, k, v, g = split_columns(h @ w_in)
    br_conv = short_conv_mixer(cb, cc, cx, conv_w) @ w_br_conv
    br_sgu = spatial_gating(su, sv, sgu_ln, sgu_ws, sgu_b) @ w_br_sgu
    q = apply_axial_rope(rms_norm(q.reshape(bsz, s, N_Q_HEADS, HEAD_DIM), q_norm), tables)
    k = apply_axial_rope(rms_norm(k.reshape(bsz, s, N_KV_HEADS, HEAD_DIM), k_norm), tables)
    v = v.reshape(bsz, s, N_KV_HEADS, HEAD_DIM)
    br_attn = gqa_attention(q, k, v) @ w_br_attn
    gates = jax.nn.sigmoid(g.reshape(bsz, s, N_BRANCH, D_MODEL) + gate_bias)
    merged = gates[:, :, 0] * br_conv + gates[:, :, 1] * br_sgu + gates[:, :, 2] * br_attn
    x = x + merged @ w_out
    return x + swiglu(rms_norm(x, norm_ffn), w_ffn_in, w_ffn_out)


def setup_inputs(seed: int = 0) -> dict:
    key = jax.random.key(seed)
    ks = jax.random.split(key, 20)

    def nrm(k, shape, scale):
        return jax.random.normal(k, shape, jnp.float32) * scale

    return {
        'x_prompt': nrm(ks[0], (BATCH, SEQ, D_MODEL), 1.0),
        'x_sample': nrm(ks[1], (DEC_BATCH, DEC_SEQ, D_MODEL), 1.0),
        'norm_mix': 1.0 + nrm(ks[2], (DEPTH, D_MODEL), 0.02),
        'w_in': nrm(ks[3], (DEPTH, D_MODEL, D_IN), D_MODEL ** -0.5),
        'gate_bias': nrm(ks[4], (DEPTH, N_BRANCH, D_MODEL), 0.01),
        'conv_w': nrm(ks[5], (DEPTH, CONV_WIDTH, D_CONV), CONV_WIDTH ** -0.5),
        'sgu_ln': 1.0 + nrm(ks[6], (DEPTH, D_SGU), 0.02),
        'sgu_ws': nrm(ks[7], (DEPTH, SGU_GROUPS, CHUNK, CHUNK), CHUNK ** -0.5),
        'sgu_b': 1.0 + nrm(ks[8], (DEPTH, SGU_GROUPS, CHUNK), 0.02),
        'q_norm': 1.0 + nrm(ks[9], (DEPTH, HEAD_DIM), 0.02),
        'k_norm': 1.0 + nrm(ks[10], (DEPTH, HEAD_DIM), 0.02),
        'w_br_conv': nrm(ks[11], (DEPTH, D_CONV, D_MODEL), D_CONV ** -0.5),
        'w_br_sgu': nrm(ks[12], (DEPTH, D_SGU, D_MODEL), D_SGU ** -0.5),
        'w_br_attn': nrm(ks[13], (DEPTH, D_ATTN, D_MODEL), D_ATTN ** -0.5),
        'w_out': nrm(ks[14], (DEPTH, D_MODEL, D_MODEL), D_MODEL ** -0.5),
        'norm_ffn': 1.0 + nrm(ks[15], (DEPTH, D_MODEL), 0.02),
        'w_ffn_in': nrm(ks[16], (DEPTH, D_MODEL, 2 * D_FF), D_MODEL ** -0.5),
        'w_ffn_out': nrm(ks[17], (DEPTH, D_FF, D_MODEL), D_FF ** -0.5),
        'norm_final': 1.0 + nrm(ks[18], (D_MODEL,), 0.02),
    }


def reference(x_prompt, x_sample, norm_mix, w_in, gate_bias, conv_w, sgu_ln, sgu_ws, sgu_b, q_norm, k_norm,
              w_br_conv, w_br_sgu, w_br_attn, w_out, norm_ffn, w_ffn_in, w_ffn_out, norm_final):
    def trunk(x):
        tables = axial_rope_tables(x.shape[1])
        for l in range(DEPTH):
            x = encoder_layer(x, tables, norm_mix[l], w_in[l], gate_bias[l], conv_w[l], sgu_ln[l], sgu_ws[l],
                              sgu_b[l], q_norm[l], k_norm[l], w_br_conv[l], w_br_sgu[l], w_br_attn[l],
                              w_out[l], norm_ffn[l], w_ffn_in[l], w_ffn_out[l])
        return rms_norm(x, norm_final)

    y_prompt = trunk(x_prompt)
    y_sample = trunk(x_sample)
    return (y_prompt, y_sample)
```

```cpp
#include <hip/hip_runtime.h>
#ifndef RELAX
#define RELAX 0
#endif
#include <cstdio>
#include <cstdint>

#define LAS __attribute__((address_space(3)))
typedef unsigned short bf16_t;
typedef short bf16x8 __attribute__((ext_vector_type(8)));
typedef short s16x4 __attribute__((ext_vector_type(4)));
typedef float f32x2 __attribute__((ext_vector_type(2)));
typedef float f32x4 __attribute__((ext_vector_type(4)));
typedef float f32x16 __attribute__((ext_vector_type(16)));
typedef unsigned u32x2 __attribute__((ext_vector_type(2)));
typedef unsigned u32x4 __attribute__((ext_vector_type(4)));

constexpr int DM = 2048, DIN = 14336, DFF = 5632, NFF2 = 11264, HD = 128, NQH = 16, NKV = 4, SEQ = 8192, DEPTH = 4;
constexpr int TG = 16384, NGRP = 3, NTOK = 49152;
constexpr int ZC_CB = 0, ZC_CC = 1024, ZC_CX = 2048, ZC_SU = 3072, ZC_SV = 4096, ZC_Q = 5120, ZC_K = 7168, ZC_V = 7680, ZC_G = 8192;
constexpr int MIXW = 4096;
constexpr float EPS = 1e-6f;

constexpr size_t MiB = (size_t)1 << 20;
constexpr size_t WS_CTL = 0, CTL_ZERO_BYTES = 64 * 1024;
constexpr size_t WS_ROPE = 1 * MiB;
constexpr size_t WS_SGUW = 2 * MiB;
constexpr size_t WS_WIN = 4 * MiB;
constexpr size_t WS_WBR = WS_WIN + 224 * MiB;
constexpr size_t WS_WOUT = WS_WBR + 64 * MiB;
constexpr size_t WS_WFI = WS_WOUT + 32 * MiB;
constexpr size_t WS_WFO = WS_WFI + 176 * MiB;
constexpr size_t WS_H = WS_WFO + 88 * MiB;
constexpr size_t WS_Z = WS_H + 64 * MiB;
constexpr size_t WS_MIX = WS_Z + 448 * MiB;
constexpr size_t WS_MRG = WS_MIX + 128 * MiB;
constexpr size_t WS_ACT = WS_MRG + 64 * MiB;
constexpr size_t WS_XBA = WS_ACT + 176 * MiB;
constexpr size_t WS_SS = WS_XBA + 192 * MiB;
constexpr size_t WS_KT = WS_SS + 1 * MiB;
constexpr size_t WS_VT = WS_KT + 16 * MiB;
constexpr size_t WS_END = WS_VT + 16 * MiB;
constexpr float SS_SCALE = 1024.0f, SS_INV = 1.0f / 1024.0f;

constexpr int RING_BYTES = 131072, LDSCTL_OFF = RING_BYTES, LDS_BYTES = 147456;

#define LDS_WAIT() asm volatile("s_waitcnt lgkmcnt(0)" ::: "memory")
#define VM_WAIT() asm volatile("s_waitcnt vmcnt(0)" ::: "memory")

__device__ __forceinline__ unsigned cvt_pk_bf16(float lo, float hi) { unsigned r; asm volatile("v_cvt_pk_bf16_f32 %0, %1, %2" : "=v"(r) : "v"(lo), "v"(hi)); return r; }
__device__ __forceinline__ float bf_lo(unsigned w) { return __uint_as_float(w << 16); }
__device__ __forceinline__ float bf_hi(unsigned w) { return __uint_as_float(w & 0xffff0000u); }
template <int X> __device__ __forceinline__ float swz_xor(float v) { return __int_as_float(__builtin_amdgcn_ds_swizzle(__float_as_int(v), (X << 10) | 0x1F)); }
__device__ __forceinline__ float xor32_sum(float v) { auto r = __builtin_amdgcn_permlane32_swap(__float_as_uint(v), __float_as_uint(v), false, false); return __uint_as_float(r[0]) + __uint_as_float(r[1]); }
__device__ __forceinline__ float wave_sum(float v) {
    v += swz_xor<1>(v); v += swz_xor<2>(v); v += swz_xor<4>(v); v += swz_xor<8>(v); v += swz_xor<16>(v);
    return xor32_sum(v);
}
__device__ __forceinline__ float fast_exp(float x) { return __builtin_amdgcn_exp2f(x * 1.4426950408889634f); }
__device__ __forceinline__ float clampg(float x) { return fminf(fmaxf(x, -30.f), 30.f); }

#define XB_TMO      128
#define XB_XCNT(j)  (256  + 64 * (j))
#define XB_XSUB(j)  (1280 + 64 * (j))
#define XB_XGEN(j)  (2304 + 64 * (j))
#define XB_TOP      3328
#define XB_TOPGEN   3392
#define XCD_BAR_WORDS 3456
#define XB_SPIN_CAP (1u << 18)

#define XB_G(p) ((__attribute__((address_space(1))) unsigned*)(p))
__device__ __forceinline__ unsigned xb_ld(unsigned* p)              { return __hip_atomic_load(XB_G(p), __ATOMIC_RELAXED, __HIP_MEMORY_SCOPE_AGENT); }
__device__ __forceinline__ unsigned xb_add(unsigned* p, unsigned v) { return __hip_atomic_fetch_add(XB_G(p), v, __ATOMIC_RELAXED, __HIP_MEMORY_SCOPE_AGENT); }
__device__ __forceinline__ unsigned xb_xcc_id() { return (unsigned)__builtin_amdgcn_s_getreg((3 << 11) | 20) & 0xFu; }
#define XB_SPIN(cond, bar) do { unsigned _sp = 0; while (cond) { __builtin_amdgcn_s_sleep(1); \
    if ((++_sp & 255u) == 0u) { if (xb_ld(&(bar)[XB_TMO])) break; if (_sp > XB_SPIN_CAP) { (void)xb_add(&(bar)[XB_TMO], 1u); break; } } } } while (0)

struct XcdBarrier { unsigned* bar; unsigned x; volatile LAS unsigned* st; };

__device__ __forceinline__ XcdBarrier xcd_barrier_post(unsigned* bar, volatile LAS unsigned* st) {
    XcdBarrier b; b.bar = bar; b.x = xb_xcc_id(); b.st = st;
    if (threadIdx.x == 0) (void)xb_add(&bar[XB_XCNT(b.x)], 1u);
    return b;
}
__device__ __forceinline__ void xcd_barrier_complete(unsigned* bar, unsigned x, unsigned& nloc, unsigned& nx) {
    const unsigned G = gridDim.x * gridDim.y * gridDim.z;
    unsigned sum, cnt, mine, sp = 0u;
    for (;;) {
        sum = 0u; cnt = 0u; mine = 0u;
#pragma unroll
        for (unsigned j = 0; j < 16; ++j) { const unsigned c = xb_ld(&bar[XB_XCNT(j)]); sum += c; cnt += (c > 0u) ? 1u : 0u; mine = (j == x) ? c : mine; }
        if (sum == G) break;
        __builtin_amdgcn_s_sleep(1);
        if ((++sp & 255u) == 0u) { if (xb_ld(&bar[XB_TMO])) break; if (sp > XB_SPIN_CAP) { (void)xb_add(&bar[XB_TMO], 1u); break; } }
    }
    nloc = mine > 0u ? mine : 1u; nx = cnt > 0u ? cnt : 1u;
}
__device__ __forceinline__ void xcd_barrier(const XcdBarrier& b) {
    asm volatile("s_waitcnt vmcnt(0)" ::: "memory");
    __syncthreads();
    if (threadIdx.x == 0) {
        unsigned* bar = b.bar; unsigned bx_ = b.x; asm volatile("" : "+s"(bar), "+s"(bx_));
        __builtin_amdgcn_s_waitcnt(0);
        unsigned nloc = b.st[0], nx = b.st[1];
        if (nloc == 0u) { xcd_barrier_complete(bar, bx_, nloc, nx); b.st[0] = nloc; b.st[1] = nx; }
        const unsigned old = xb_add(&bar[XB_XSUB(bx_)], 1u);
        const unsigned gen = old / nloc;
        if (old + 1u == (gen + 1u) * nloc) {
            __builtin_amdgcn_fence(__ATOMIC_RELEASE, "agent");
            asm volatile("s_waitcnt vmcnt(0)" ::: "memory");
            const unsigned og = xb_add(&bar[XB_TOP], 1u);
            const unsigned tg = og / nx;
            if (og + 1u == (tg + 1u) * nx) xb_add(&bar[XB_TOPGEN], 1u);
            else XB_SPIN(xb_ld(&bar[XB_TOPGEN]) == tg, bar);
            __builtin_amdgcn_fence(__ATOMIC_ACQUIRE, "agent");
            xb_add(&bar[XB_XGEN(bx_)], 1u);
            asm volatile("s_waitcnt vmcnt(0)" ::: "memory");
        } else {
            XB_SPIN(xb_ld(&bar[XB_XGEN(bx_)]) == gen, bar);
            __builtin_amdgcn_fence(__ATOMIC_ACQUIRE, "agent");
            asm volatile("s_waitcnt vmcnt(0)" ::: "memory");
        }
    }
    __syncthreads();
}

namespace pg8 {
constexpr int BM = 256, BK = 64, HALF = 128, HTB = HALF * BK * 2, STAGE_BYTES = 8 * HTB, NXCD = 8, WGM = 8;
__host__ __device__ __forceinline__ int lds_byte(int r, int c) { const int st = (r >> 4) * 2 + (c >> 5), rr = r & 15, cc = c & 31, ob = rr * 64 + cc * 2; return st * 1024 + (ob ^ (((ob >> 9) & 1) << 5)); }
__host__ __device__ __forceinline__ void stage_rc(int b, int& R, int& C) { const int st = b / 1024, sb = b % 1024, swz = sb ^ (((sb >> 9) & 1) << 5); R = (st >> 1) * 16 + swz / 64; C = (st & 1) * 32 + (swz % 64) / 2; }
__host__ __device__ __forceinline__ int perm32(int rho) { const int n = rho >> 4, i = rho & 15; return 8 * (i >> 2) + 4 * n + (i & 3); }

struct Unit { int pm, pn; };

template <int M, int N> struct StaticOrder {
    static constexpr int nM = M / BM, nN = N / BM, nwg = nM * nN;
    int G, c;
    __device__ __forceinline__ bool next(int i, Unit& u) const {
        const long L = (long)i * G + c; if (L >= nwg) return false;
        int wgid = (int)L; { const int q = nwg / NXCD, r = nwg % NXCD, xcd = wgid % NXCD, off = wgid / NXCD; wgid = (xcd < r ? xcd * (q + 1) : r * (q + 1) + (xcd - r) * q) + off; }
        const int nig = WGM * nN, gid = wgid / nig, fm = gid * WGM, gsz = (nM - fm) < WGM ? (nM - fm) : WGM;
        u.pm = fm + ((wgid % nig) % gsz); u.pn = (wgid % nig) / gsz; return true;
    }
};

typedef f32x4 Acc[2][2][4][2];

__device__ __forceinline__ void st_b128(void* p, u32x4 w) { asm volatile("global_store_dwordx4 %0, %1, off\n\ts_nop 1" :: "v"(p), "v"(w) : "memory"); }
__device__ __forceinline__ void st_b128_wt(void* p, u32x4 w) { asm volatile("global_store_dwordx4 %0, %1, off sc0 sc1\n\ts_nop 1" :: "v"(p), "v"(w) : "memory"); }
__device__ __forceinline__ unsigned ld_u32_asm(const unsigned* p) { unsigned v; asm volatile("global_load_dword %0, %1, off" : "=v"(v) : "v"(p) : "memory"); return v; }
__device__ __forceinline__ void atomic_add_u32_noret(unsigned* p, unsigned v) { asm volatile("global_atomic_add %0, %1, off" :: "v"(p), "v"(v) : "memory"); }
__device__ __forceinline__ float rstd_from(unsigned s) { return __builtin_amdgcn_rsqf((float)s * (SS_INV / DM) + EPS); }
typedef unsigned Pre[8];
struct EpiBf16 {
    static constexpr bool PERM = true, HOOK = false, PRE = true; static constexpr int TAIL = 24;
    __device__ __forceinline__ void prefetch(Pre& pre, const Unit& u, int wr, int fr) const {
#pragma unroll
        for (int i = 0; i < 8; ++i) pre[i] = ld_u32_asm(ss + (u.pm * BM + wr * 64 + fr + (i >> 2) * HALF + (i & 3) * 16)); }
    bf16_t* O; int ldc; const unsigned* ss;
    __device__ __forceinline__ void hook(Acc&, const Unit&, int, int, int, int, int) const {}
    __device__ __forceinline__ void operator()(Acc& acc, const Unit& u, int wr, int wc, int fr, int fq, const Pre& pre) const {
        int row0 = u.pm * BM + wr * 64 + fr; asm volatile("" : "+v"(row0)); const int col0 = u.pn * BM + wc * 32 + 8 * fq;
#pragma unroll
        for (int ai = 0; ai < 2; ++ai)
#pragma unroll
            for (int m = 0; m < 4; ++m) { const size_t r = (size_t)(row0 + ai * HALF + m * 16); bf16_t* rowp = O + r * ldc + col0; const float rs = rstd_from(pre[ai * 4 + m]);
#pragma unroll
                for (int bj = 0; bj < 2; ++bj) { const f32x4 v0 = acc[ai][bj][m][0] * rs, v1 = acc[ai][bj][m][1] * rs;
                    u32x4 w; w.x = cvt_pk_bf16(v0[0], v0[1]); w.y = cvt_pk_bf16(v0[2], v0[3]); w.z = cvt_pk_bf16(v1[0], v1[1]); w.w = cvt_pk_bf16(v1[2], v1[3]);
                    st_b128_wt(rowp + bj * HALF, w); } }
    }
};
struct EpiSwiGLU {
    static constexpr bool PERM = true, HOOK = false, PRE = true; static constexpr int TAIL = 16;
    __device__ __forceinline__ void prefetch(Pre& pre, const Unit& u, int wr, int fr) const {
#pragma unroll
        for (int i = 0; i < 8; ++i) pre[i] = ld_u32_asm(ss + (u.pm * BM + wr * 64 + fr + (i >> 2) * HALF + (i & 3) * 16)); }
    bf16_t* O; int ldc; const unsigned* ss;
    __device__ __forceinline__ void hook(Acc&, const Unit&, int, int, int, int, int) const {}
    __device__ __forceinline__ void operator()(Acc& acc, const Unit& u, int wr, int wc, int fr, int fq, const Pre& pre) const {
        int row0 = u.pm * BM + wr * 64 + fr; asm volatile("" : "+v"(row0)); const int col0 = u.pn * HALF + wc * 32 + 8 * fq;
#pragma unroll
        for (int ai = 0; ai < 2; ++ai)
#pragma unroll
            for (int m = 0; m < 4; ++m) { const size_t r = (size_t)(row0 + ai * HALF + m * 16); bf16_t* rowp = O + r * ldc + col0; const float rs = rstd_from(pre[ai * 4 + m]);
                float o[8];
#pragma unroll
                for (int n = 0; n < 2; ++n)
#pragma unroll
                    for (int e = 0; e < 4; ++e) { const float g = acc[ai][0][m][n][e] * rs, up = acc[ai][1][m][n][e] * rs;
                        o[n * 4 + e] = g * __builtin_amdgcn_rcpf(1.0f + fast_exp(-g)) * up; }
                u32x4 w; w.x = cvt_pk_bf16(o[0], o[1]); w.y = cvt_pk_bf16(o[2], o[3]); w.z = cvt_pk_bf16(o[4], o[5]); w.w = cvt_pk_bf16(o[6], o[7]);
                st_b128_wt(rowp, w); }
    }
};
struct EpiResidSS {
    static constexpr bool PERM = true, HOOK = false, PRE = false; static constexpr int TAIL = 24;
    __device__ __forceinline__ void prefetch(Pre&, const Unit&, int, int) const {}
    const bf16_t* base; bf16_t* xb; unsigned* ss;
    __device__ __forceinline__ void hook(Acc&, const Unit&, int, int, int, int, int) const {}
    __device__ __forceinline__ void operator()(Acc& acc, const Unit& u, int wr, int wc, int fr, int fq, const Pre& pre) const {
        int row0 = u.pm * BM + wr * 64 + fr; asm volatile("" : "+v"(row0)); const int col0 = u.pn * BM + wc * 32 + 8 * fq;
        u32x4 b[8][2];
#pragma unroll
        for (int i = 0; i < 8; ++i)
#pragma unroll
            for (int bj = 0; bj < 2; ++bj) b[i][bj] = *(const u32x4*)(base + (size_t)(row0 + (i >> 2) * HALF + (i & 3) * 16) * DM + col0 + bj * HALF);
        asm volatile("" : "+v"(b[0][0]), "+v"(b[0][1]), "+v"(b[1][0]), "+v"(b[1][1]), "+v"(b[2][0]), "+v"(b[2][1]), "+v"(b[3][0]), "+v"(b[3][1]));
        asm volatile("" : "+v"(b[4][0]), "+v"(b[4][1]), "+v"(b[5][0]), "+v"(b[5][1]), "+v"(b[6][0]), "+v"(b[6][1]), "+v"(b[7][0]), "+v"(b[7][1]));
#pragma unroll
        for (int i = 0; i < 8; ++i) { const size_t r = (size_t)(row0 + (i >> 2) * HALF + (i & 3) * 16), off = r * DM + col0; float sq = 0.f;
#pragma unroll
            for (int bj = 0; bj < 2; ++bj) { const u32x4 bb = b[i][bj];
                const f32x4 v0 = (f32x4){bf_lo(bb.x), bf_hi(bb.x), bf_lo(bb.y), bf_hi(bb.y)} + acc[i >> 2][bj][i & 3][0], v1 = (f32x4){bf_lo(bb.z), bf_hi(bb.z), bf_lo(bb.w), bf_hi(bb.w)} + acc[i >> 2][bj][i & 3][1];
                u32x4 w; w.x = cvt_pk_bf16(v0[0], v0[1]); w.y = cvt_pk_bf16(v0[2], v0[3]); w.z = cvt_pk_bf16(v1[0], v1[1]); w.w = cvt_pk_bf16(v1[2], v1[3]);
                st_b128(xb + off + bj * HALF, w);
                sq += (v0[0] * v0[0] + v0[1] * v0[1]) + (v0[2] * v0[2] + v0[3] * v0[3]) + (v1[0] * v1[0] + v1[1] * v1[1]) + (v1[2] * v1[2] + v1[3] * v1[3]); }
            sq += swz_xor<16>(sq); sq = xor32_sum(sq);
            if (fq == 0) atomic_add_u32_noret(ss + r, (unsigned)(sq * SS_SCALE + 0.5f)); }
    }
};
struct EpiMerge {
    static constexpr bool PERM = true, HOOK = true, PRE = false; static constexpr int TAIL = 8;
    __device__ __forceinline__ void prefetch(Pre&, const Unit&, int, int) const {}
    const bf16_t* zg; const float* gb; bf16_t* O;
    __device__ __forceinline__ void hook(Acc& acc, const Unit& u, int stage, int wr, int wc, int fr, int fq) const {
        int row0 = u.pm * BM + wr * 64 + fr; asm volatile("" : "+v"(row0)); const int col0 = u.pn * BM + wc * 32 + 8 * fq;
#pragma unroll
        for (int bj = 0; bj < 2; ++bj) {
            f32x4 ba[2], bb[2];
#pragma unroll
            for (int n = 0; n < 2; ++n) { ba[n] = *(const f32x4*)(gb + stage * DM + col0 + bj * HALF + 4 * n); bb[n] = *(const f32x4*)(gb + (stage + 1) * DM + col0 + bj * HALF + 4 * n); }
#pragma unroll
            for (int ai = 0; ai < 2; ++ai) { u32x4 ga[4], gv[4];
#pragma unroll
                for (int m = 0; m < 4; ++m) { const bf16_t* rowp = zg + (size_t)(row0 + ai * HALF + m * 16) * DIN + stage * DM + col0 + bj * HALF;
                    ga[m] = *(const u32x4*)rowp; gv[m] = *(const u32x4*)(rowp + DM); }
                asm volatile("" : "+v"(ga[0]), "+v"(ga[1]), "+v"(ga[2]), "+v"(ga[3]), "+v"(gv[0]), "+v"(gv[1]), "+v"(gv[2]), "+v"(gv[3]));
#pragma unroll
                for (int m = 0; m < 4; ++m)
#pragma unroll
                    for (int n = 0; n < 2; ++n)
#pragma unroll
                        for (int e = 0; e < 4; ++e) { const unsigned wa = ga[m][n * 2 + (e >> 1)], wb = gv[m][n * 2 + (e >> 1)];
                            const float xa = ((e & 1) ? bf_hi(wa) : bf_lo(wa)) + ba[n][e], xb = ((e & 1) ? bf_hi(wb) : bf_lo(wb)) + bb[n][e];
                            const float ea = fast_exp(-clampg(xa)), eb = fast_exp(-clampg(xb));
                            acc[ai][bj][m][n][e] *= (1.0f + eb) * __builtin_amdgcn_rcpf(1.0f + ea); }
                asm volatile("" ::: "memory"); }
        }
    }
    __device__ __forceinline__ void operator()(Acc& acc, const Unit& u, int wr, int wc, int fr, int fq, const Pre& pre) const {
        int row0 = u.pm * BM + wr * 64 + fr; asm volatile("" : "+v"(row0)); const int col0 = u.pn * BM + wc * 32 + 8 * fq;
#pragma unroll
        for (int bj = 0; bj < 2; ++bj) {
            f32x4 bc[2]; u32x4 gc[8];
#pragma unroll
            for (int n = 0; n < 2; ++n) bc[n] = *(const f32x4*)(gb + 2 * DM + col0 + bj * HALF + 4 * n);
#pragma unroll
            for (int i = 0; i < 8; ++i) gc[i] = *(const u32x4*)(zg + (size_t)(row0 + (i >> 2) * HALF + (i & 3) * 16) * DIN + 2 * DM + col0 + bj * HALF);
            asm volatile("" : "+v"(gc[0]), "+v"(gc[1]), "+v"(gc[2]), "+v"(gc[3]), "+v"(gc[4]), "+v"(gc[5]), "+v"(gc[6]), "+v"(gc[7]));
#pragma unroll
            for (int i = 0; i < 8; ++i) { float o[8];
#pragma unroll
                for (int n = 0; n < 2; ++n)
#pragma unroll
                    for (int e = 0; e < 4; ++e) { const unsigned wcw = gc[i][n * 2 + (e >> 1)]; const float xc = ((e & 1) ? bf_hi(wcw) : bf_lo(wcw)) + bc[n][e];
                        o[n * 4 + e] = acc[i >> 2][bj][i & 3][n][e] * __builtin_amdgcn_rcpf(1.0f + fast_exp(-clampg(xc))); }
                u32x4 w; w.x = cvt_pk_bf16(o[0], o[1]); w.y = cvt_pk_bf16(o[2], o[3]); w.z = cvt_pk_bf16(o[4], o[5]); w.w = cvt_pk_bf16(o[6], o[7]);
                st_b128(O + (size_t)(row0 + (i >> 2) * HALF + (i & 3) * 16) * DM + col0 + bj * HALF, w); }
            asm volatile("" ::: "memory");
        }
    }
};

template <class Epi, int M, int N, int K>
__device__ __forceinline__ void gemm_phase(LAS unsigned char* lds, const bf16_t* gA, const bf16_t* gBt, int G_, int c_, const Epi& E) {
    int tid = threadIdx.x; asm volatile("" : "+v"(tid));
    const int wid = __builtin_amdgcn_readfirstlane(tid >> 6), lane = tid & 63, wr = wid >> 2, wc = wid & 3, fr = lane & 15, fq = lane >> 4;
    constexpr int nt = K / BK;
    StaticOrder<M, N> S; S.G = G_; S.c = c_;
    unsigned voffA[2], voffB[2];
#pragma unroll
    for (int i = 0; i < 2; ++i) { int R, C; stage_rc(tid * 16 + i * 8192, R, C); const int Rb = Epi::PERM ? ((R & ~31) + perm32(R & 31)) : R;
        voffA[i] = (unsigned)(R * K + C) * 2u; voffB[i] = (unsigned)(Rb * K + C) * 2u; }
    constexpr size_t kstep = (size_t)(BK * 2);
    constexpr size_t hstep = (size_t)HALF * K * 2;
    constexpr size_t tstep = 2 * hstep;
    const unsigned ldsw = (unsigned)wid * 1024u;
    const int aoff = lds_byte(wr * 64 + fr, fq * 8), boff = lds_byte(wc * 32 + fr, fq * 8);
#define PG8_SA(b, h) (((b) * 2 + (h)) * HTB)
#define PG8_SB(b, h) ((4 + (b) * 2 + (h)) * HTB)
    const unsigned ldsb = (unsigned)(uintptr_t)lds + ldsw;
#define PG8_STAGE(bufoff, gbase, voff) do { _Pragma("unroll") for (int _i = 0; _i < 2; ++_i) { \
        asm volatile("s_mov_b32 m0, %2\n\ts_nop 0\n\tglobal_load_lds_dwordx4 %0, %1" :: "v"((voff)[_i]), "s"((const char*)(gbase)), "s"(ldsb + (unsigned)((bufoff) + _i * 8192)) : "memory"); } } while (0)
#define PG8_LDA(dst, b, h) do { _Pragma("unroll") for (int m = 0; m < 4; ++m) _Pragma("unroll") for (int k = 0; k < 2; ++k) dst[m][k] = *(const LAS bf16x8*)(lds + PG8_SA(b, h) + aoff + m * 2048 + k * 1024); } while (0)
#define PG8_LDB(dst, b, h) do { _Pragma("unroll") for (int n = 0; n < 2; ++n) _Pragma("unroll") for (int k = 0; k < 2; ++k) dst[n][k] = *(const LAS bf16x8*)(lds + PG8_SB(b, h) + boff + n * 2048 + k * 1024); } while (0)
#define PG8_MMA(ai, bj, At, Bt) do { __builtin_amdgcn_s_setprio(1); _Pragma("unroll") for (int m = 0; m < 4; ++m) _Pragma("unroll") for (int n = 0; n < 2; ++n) _Pragma("unroll") for (int k = 0; k < 2; ++k) \
        acc[ai][bj][m][n] = __builtin_amdgcn_mfma_f32_16x16x32_bf16(Bt[n][k], At[m][k], acc[ai][bj][m][n], 0, 0, 0); __builtin_amdgcn_s_setprio(0); } while (0)
#define PG8_WAIT_V(n) asm volatile("s_waitcnt vmcnt(" #n ")" ::: "memory")
#define PG8_WAIT_L(n) asm volatile("s_waitcnt lgkmcnt(" #n ")" ::: "memory")
#define PG8_WAIT_V8R_(rel, N) asm volatile("s_waitcnt vmcnt(" #N ")\n\ts_cmp_lg_u32 %0, 0\n\ts_cbranch_scc1 1f\n\ts_waitcnt vmcnt(8)\n1:" :: "s"(rel) : "memory", "scc")
#define PG8_WAIT_V8R(rel) do { static_assert(Epi::TAIL == 8 || Epi::TAIL == 16 || Epi::TAIL == 24, "TAIL"); \
        if constexpr (Epi::TAIL == 8) PG8_WAIT_V8R_(rel, 16); else if constexpr (Epi::TAIL == 16) PG8_WAIT_V8R_(rel, 24); else PG8_WAIT_V8R_(rel, 32); } while (0)
#define PG8_BAR __builtin_amdgcn_s_barrier()
#define PG8_SCHED __builtin_amdgcn_sched_barrier(0)
    Unit cur, nxt; int ui = 0;
    if (!S.next(0, cur)) return;
    Acc acc;
#pragma unroll
    for (int a = 0; a < 2; ++a)
#pragma unroll
        for (int b = 0; b < 2; ++b)
#pragma unroll
            for (int m = 0; m < 4; ++m)
#pragma unroll
                for (int n = 0; n < 2; ++n) acc[a][b][m][n] = (f32x4){0.f, 0.f, 0.f, 0.f};
    bf16x8 At[4][2], B0[2][2], B1[2][2];
    const char* cA = (const char*)gA + (size_t)cur.pm * tstep; const char* cB = (const char*)gBt + (size_t)cur.pn * tstep;
    Pre pre;
    if constexpr (Epi::PRE) E.prefetch(pre, cur, wr, fr);
    PG8_STAGE(PG8_SB(0, 0), cB, voffB); PG8_STAGE(PG8_SB(0, 1), cB + hstep, voffB); PG8_STAGE(PG8_SA(0, 0), cA, voffA); PG8_STAGE(PG8_SA(0, 1), cA + hstep, voffA);
    if (wr == 1) PG8_BAR;
    PG8_WAIT_V(2); PG8_BAR;
    PG8_STAGE(PG8_SB(1, 0), cB + kstep, voffB); PG8_STAGE(PG8_SA(1, 0), cA + kstep, voffA); PG8_STAGE(PG8_SB(1, 1), cB + hstep + kstep, voffB);
    PG8_WAIT_V(6); PG8_BAR;
    __builtin_amdgcn_s_waitcnt(0x0F70);
    for (;;) {
        const bool has_next = S.next(ui + 1, nxt);
        const char* nA = has_next ? (const char*)gA + (size_t)nxt.pm * tstep : cA; const char* nB = has_next ? (const char*)gBt + (size_t)nxt.pn * tstep : cB;
        for (int t = 0; t < nt; t += 2) {
            if constexpr (Epi::HOOK) { if (t == 16 || t == 32) { PG8_SCHED; E.hook(acc, cur, t == 16 ? 0 : 1, wr, wc, fr, fq); PG8_WAIT_V(0); PG8_SCHED; } }
            const bool last = (t == nt - 2);
            const int rel = __builtin_amdgcn_readfirstlane((t == 0 && ui > 0 && RELAX) ? 1 : 0);
            const char* a1 = cA + (size_t)(t + 1) * kstep;
            const char* a2 = last ? nA : cA + (size_t)(t + 2) * kstep; const char* b2 = last ? nB : cB + (size_t)(t + 2) * kstep;
            const char* a3 = a2 + kstep; const char* b3 = b2 + kstep;
            PG8_LDB(B0, 0, 0); PG8_LDB(B1, 0, 1); PG8_SCHED; PG8_LDA(At, 0, 0); PG8_STAGE(PG8_SA(1, 1), a1 + hstep, voffA);
            PG8_WAIT_V8R(rel); PG8_WAIT_L(0); PG8_BAR; PG8_MMA(0, 0, At, B0); PG8_MMA(0, 1, At, B1); PG8_BAR; PG8_SCHED;
            PG8_LDA(At, 0, 1); PG8_STAGE(PG8_SB(0, 0), b2, voffB); PG8_STAGE(PG8_SB(0, 1), b2 + hstep, voffB); PG8_STAGE(PG8_SA(0, 0), a2, voffA);
            PG8_WAIT_V8R(rel); PG8_WAIT_L(0); PG8_BAR; PG8_MMA(1, 0, At, B0); PG8_MMA(1, 1, At, B1); PG8_BAR; PG8_SCHED;
            PG8_LDB(B0, 1, 0); PG8_LDB(B1, 1, 1); PG8_SCHED; PG8_LDA(At, 1, 0); PG8_STAGE(PG8_SA(0, 1), a2 + hstep, voffA);
            PG8_WAIT_V(8); PG8_WAIT_L(0); PG8_BAR; PG8_MMA(0, 0, At, B0); PG8_MMA(0, 1, At, B1); PG8_BAR; PG8_SCHED;
            PG8_LDA(At, 1, 1); PG8_STAGE(PG8_SB(1, 0), b3, voffB); PG8_STAGE(PG8_SB(1, 1), b3 + hstep, voffB); PG8_STAGE(PG8_SA(1, 0), a3, voffA);
            PG8_WAIT_V(8); PG8_WAIT_L(0); PG8_BAR; PG8_MMA(1, 0, At, B0); PG8_MMA(1, 1, At, B1); PG8_BAR; PG8_SCHED;
        }
        if (wr == 0) PG8_BAR;
        E(acc, cur, wr, wc, fr, fq, pre);
        if (!has_next) break;
        if constexpr (Epi::PRE) E.prefetch(pre, nxt, wr, fr);
#pragma unroll
        for (int a = 0; a < 2; ++a)
#pragma unroll
            for (int b = 0; b < 2; ++b)
#pragma unroll
                for (int m = 0; m < 4; ++m)
#pragma unroll
                    for (int n = 0; n < 2; ++n) acc[a][b][m][n] = (f32x4){0.f, 0.f, 0.f, 0.f};
        cur = nxt; cA = nA; cB = nB; ++ui;
        if (wr == 1) PG8_BAR;
    }
    PG8_WAIT_V(0);
    PG8_BAR;
#undef PG8_SA
#undef PG8_SB
#undef PG8_STAGE
#undef PG8_LDA
#undef PG8_LDB
#undef PG8_MMA
#undef PG8_WAIT_V
#undef PG8_WAIT_L
#undef PG8_WAIT_V8R
#undef PG8_WAIT_V8R_
#undef PG8_BAR
#undef PG8_SCHED
}
}

namespace att {
constexpr int D = 128, NW = 8, QBLK = 32, KVBLK = 64;
constexpr float SCALE = 0.088388347648318440f;
constexpr float THR = 8.f;
constexpr int LDQ = DIN, LDK = DIN, LDO = MIXW;
constexpr int SHM_V = KVBLK * D * 2, SHM_K = KVBLK * D * 2, SHM_ATTN = 2 * SHM_V + 2 * SHM_K + NW * 64 * 4;
#define KSWZ(row, colB) ((row) * 256 + ((colB) ^ (((row) & 7) << 4)))
#define SBAR() __builtin_amdgcn_sched_barrier(0)
__device__ __forceinline__ int crow(int r, int hi) { return (r & 3) + 8 * (r >> 2) + 4 * hi; }

__device__ __forceinline__ void partialSM(f32x16& p0, f32x16& p1, float& m_reg, float& mn, float& alpha) {
  constexpr float C = SCALE * 1.4426950408889634f;
  float pmax = p0[0];
#pragma unroll
  for (int r = 1; r < 16; ++r) pmax = fmaxf(pmax, p0[r]);
#pragma unroll
  for (int r = 0; r < 16; ++r) pmax = fmaxf(pmax, p1[r]);
  { auto rr = __builtin_amdgcn_permlane32_swap(__float_as_uint(pmax), __float_as_uint(pmax), false, false);
    pmax = fmaxf(__uint_as_float(rr[0]), __uint_as_float(rr[1])); }
  if (__builtin_expect(__all(pmax - m_reg <= THR / SCALE), 1)) { mn = m_reg; alpha = 1.f; }
  else { mn = fmaxf(m_reg, pmax); alpha = __builtin_amdgcn_exp2f((m_reg - mn) * C); m_reg = mn; }
  float mnC = -mn * C;
#pragma unroll
  for (int r = 0; r < 16; ++r) p0[r] = fmaf(p0[r], C, mnC);
#pragma unroll
  for (int r = 0; r < 16; ++r) p1[r] = fmaf(p1[r], C, mnC);
#pragma unroll
  for (int r = 0; r < 16; ++r) p0[r] = __builtin_amdgcn_exp2f(p0[r]);
}
__device__ __forceinline__ void finishSM(f32x16& p0, f32x16& p1, float alpha, float& l_reg, bf16x8& pa0, bf16x8& pa1, bf16x8& pa2, bf16x8& pa3) {
#pragma unroll
  for (int r = 0; r < 16; ++r) p1[r] = __builtin_amdgcn_exp2f(p1[r]);
  float ps = 0;
#pragma unroll
  for (int r = 0; r < 16; ++r) ps += p0[r];
#pragma unroll
  for (int r = 0; r < 16; ++r) ps += p1[r];
  { auto rr = __builtin_amdgcn_permlane32_swap(__float_as_uint(ps), __float_as_uint(ps), false, false);
    ps = __uint_as_float(rr[0]) + __uint_as_float(rr[1]); }
  l_reg = l_reg * alpha + ps;
#define PK8(P, BASE, OUT) do { u32x4 w = {cvt_pk_bf16(P[BASE + 0], P[BASE + 1]), cvt_pk_bf16(P[BASE + 2], P[BASE + 3]), cvt_pk_bf16(P[BASE + 4], P[BASE + 5]), cvt_pk_bf16(P[BASE + 6], P[BASE + 7])}; \
    OUT = *reinterpret_cast<bf16x8*>(&w); } while (0)
  PK8(p0, 0, pa0); PK8(p0, 8, pa1); PK8(p1, 0, pa2); PK8(p1, 8, pa3);
#undef PK8
}
__device__ __forceinline__ void qkt(f32x16& p0, f32x16& p1, const char* Ks, const bf16x8* qr, int r32, int hi) {
  p0 = f32x16{}; p1 = f32x16{};
#pragma unroll
  for (int d0 = 0; d0 < 8; ++d0) { int cb = (d0 * 16 + hi * 8) * 2;
    bf16x8 b0 = *reinterpret_cast<const bf16x8*>(Ks + KSWZ(r32, cb));
    bf16x8 b1 = *reinterpret_cast<const bf16x8*>(Ks + KSWZ(32 + r32, cb));
    p0 = __builtin_amdgcn_mfma_f32_32x32x16_bf16(b0, qr[d0], p0, 0, 0, 0);
    p1 = __builtin_amdgcn_mfma_f32_32x32x16_bf16(b1, qr[d0], p1, 0, 0, 0); }
}
__device__ __forceinline__ int v_st(int k, int c) { const int kk = (k & ~0xC) | ((k & 4) << 1) | ((k & 8) >> 1); return ((kk >> 3) * 4 + (c >> 5)) * 512 + ((kk & 7) * 32 + (c & 31)) * 2; }
__device__ __forceinline__ int v_rd_base(int lane) { return ((lane & 3) << 3) | (((lane >> 2) & 3) << 6) | (((lane >> 4) & 1) << 5) | (((lane >> 5) & 1) << 8); }
constexpr int v_rd_off(int d0, int ks, int half) { return d0 * 512 + ks * 4096 + half * 2048; }
template <int OFF> __device__ __forceinline__ s16x4 tr_read(int vb) {
  s16x4 r; asm volatile("ds_read_b64_tr_b16 %0, %1 offset:%2" : "=&v"(r) : "v"(vb), "i"(OFF) : "memory"); return r;
}
template <int D0> __device__ __forceinline__ void pv_one(f32x16& od, int vb, bf16x8 pa0, bf16x8 pa1, bf16x8 pa2, bf16x8 pa3) {
  const s16x4 l0 = tr_read<v_rd_off(D0, 0, 0)>(vb), h0 = tr_read<v_rd_off(D0, 0, 1)>(vb), l1 = tr_read<v_rd_off(D0, 1, 0)>(vb), h1 = tr_read<v_rd_off(D0, 1, 1)>(vb);
  const s16x4 l2 = tr_read<v_rd_off(D0, 2, 0)>(vb), h2 = tr_read<v_rd_off(D0, 2, 1)>(vb), l3 = tr_read<v_rd_off(D0, 3, 0)>(vb), h3 = tr_read<v_rd_off(D0, 3, 1)>(vb);
  asm volatile("s_waitcnt lgkmcnt(0)" ::: "memory"); SBAR();
#define PK(L, H) (bf16x8){L[0], L[1], L[2], L[3], H[0], H[1], H[2], H[3]}
  od = __builtin_amdgcn_mfma_f32_32x32x16_bf16(pa0, PK(l0, h0), od, 0, 0, 0);
  od = __builtin_amdgcn_mfma_f32_32x32x16_bf16(pa1, PK(l1, h1), od, 0, 0, 0);
  od = __builtin_amdgcn_mfma_f32_32x32x16_bf16(pa2, PK(l2, h2), od, 0, 0, 0);
  od = __builtin_amdgcn_mfma_f32_32x32x16_bf16(pa3, PK(l3, h3), od, 0, 0, 0);
#undef PK
}
__device__ __forceinline__ void pv_d0(f32x16* o, int vb, bf16x8 pa0, bf16x8 pa1, bf16x8 pa2, bf16x8 pa3) {
  pv_one<0>(o[0], vb, pa0, pa1, pa2, pa3); pv_one<1>(o[1], vb, pa0, pa1, pa2, pa3); pv_one<2>(o[2], vb, pa0, pa1, pa2, pa3); pv_one<3>(o[3], vb, pa0, pa1, pa2, pa3);
}

constexpr int RSLOT = 16384, LDS_KR = 0, LDS_VR = 3 * RSLOT, LDS_WS2 = 6 * RSLOT;
__device__ __forceinline__ void qkt_l(f32x16& p0, f32x16& p1, const LAS unsigned char* Ks, const bf16x8* qr, int r32, int hi) {
  p0 = f32x16{}; p1 = f32x16{};
#pragma unroll
  for (int d0 = 0; d0 < 8; ++d0) { int cb = (d0 * 16 + hi * 8) * 2;
    bf16x8 b0 = *reinterpret_cast<const LAS bf16x8*>(Ks + KSWZ(r32, cb));
    bf16x8 b1 = *reinterpret_cast<const LAS bf16x8*>(Ks + KSWZ(32 + r32, cb));
    p0 = __builtin_amdgcn_mfma_f32_32x32x16_bf16(b0, qr[d0], p0, 0, 0, 0);
    p1 = __builtin_amdgcn_mfma_f32_32x32x16_bf16(b1, qr[d0], p1, 0, 0, 0); }
}
__device__ __forceinline__ void attn_dense_body_dma(const bf16_t* __restrict__ Qb, const char* __restrict__ Kt, const char* __restrict__ Vt, bf16_t* __restrict__ Ob, int NT, LAS unsigned char* lds,
                                                    const float* __restrict__ qn, const f32x2* __restrict__ rope_row, const f32x2* __restrict__ rope_col, int pos0) {
  int tid = threadIdx.x; asm volatile("" : "+v"(tid));
  const int wid = __builtin_amdgcn_readfirstlane(tid >> 6), lane = tid & 63, r32 = lane & 31, hi = lane >> 5;
  LAS float* ws = (LAS float*)(lds + LDS_WS2) + wid * 64; LAS float* li_l = ws; LAS float* al_l = ws + 32;
  const unsigned dma_l = (unsigned)wid * 1024u;
  const unsigned dma_v = dma_l + (unsigned)lane * 16u;
  const unsigned ldsb = (unsigned)(uintptr_t)lds + dma_l;
#define DMA_PIECE(goff, gbase, ldst) do { asm volatile("s_mov_b32 m0, %2\n\ts_nop 0\n\tglobal_load_lds_dwordx4 %0, %1" :: "v"(goff), "s"(gbase), "s"(ldst) : "memory"); } while (0)
#define DMA_TILE(t, s) do { _Pragma("unroll") for (int _i = 0; _i < 2; ++_i) { \
    DMA_PIECE(dma_v + _i * 8192, Kt + (size_t)(t) * RSLOT, ldsb + (unsigned)(LDS_KR + (s) * RSLOT + _i * 8192)); \
    DMA_PIECE(dma_v + _i * 8192, Vt + (size_t)(t) * RSLOT, ldsb + (unsigned)(LDS_VR + (s) * RSLOT + _i * 8192)); } } while (0)
#define TILE_BAR() do { asm volatile("s_waitcnt vmcnt(0)" ::: "memory"); __builtin_amdgcn_s_barrier(); asm volatile("" ::: "memory"); } while (0)
  DMA_TILE(0, 0);
  float m_reg = -1e30f, l_reg = 0; f32x16 o[4] = {}; bf16x8 qr[8];
  const bf16_t* Qw = Qb + (long)(wid * QBLK + r32) * LDQ + hi * 8;
  {
    u32x4 raw[8];
#pragma unroll
    for (int d0 = 0; d0 < 8; ++d0) raw[d0] = *reinterpret_cast<const u32x4*>(Qw + d0 * 16);
    float y[8][8]; float ss = 0.f;
#pragma unroll
    for (int d0 = 0; d0 < 8; ++d0)
#pragma unroll
      for (int j = 0; j < 4; ++j) { y[d0][2 * j] = bf_lo(raw[d0][j]); y[d0][2 * j + 1] = bf_hi(raw[d0][j]); ss += y[d0][2 * j] * y[d0][2 * j] + y[d0][2 * j + 1] * y[d0][2 * j + 1]; }
    ss = xor32_sum(ss);
    const float rstd = 1.0f / sqrtf(ss * (1.0f / 128.0f) + EPS);
#pragma unroll
    for (int d0 = 0; d0 < 8; ++d0) { const f32x4 g0 = *(const f32x4*)(qn + d0 * 16 + hi * 8), g1 = *(const f32x4*)(qn + d0 * 16 + hi * 8 + 4);
#pragma unroll
      for (int j = 0; j < 4; ++j) { y[d0][j] *= rstd * g0[j]; y[d0][4 + j] *= rstd * g1[j]; } }
    const int pos = pos0 + wid * QBLK + r32;
#pragma unroll
    for (int blk = 0; blk < 2; ++blk) { const f32x2* tab = blk ? (rope_col + (pos & 63) * 32) : (rope_row + (pos >> 6) * 32);
#pragma unroll
      for (int dd = 0; dd < 2; ++dd) { const f32x4* tp = (const f32x4*)(tab + dd * 16 + hi * 8); const int da = 4 * blk + dd, db = da + 2;
#pragma unroll
        for (int j2 = 0; j2 < 4; ++j2) { const f32x4 cs = tp[j2];
          { const float x1 = y[da][2 * j2], x2 = y[db][2 * j2]; y[da][2 * j2] = x1 * cs[0] - x2 * cs[1]; y[db][2 * j2] = x2 * cs[0] + x1 * cs[1]; }
          { const float x1 = y[da][2 * j2 + 1], x2 = y[db][2 * j2 + 1]; y[da][2 * j2 + 1] = x1 * cs[2] - x2 * cs[3]; y[db][2 * j2 + 1] = x2 * cs[2] + x1 * cs[3]; } } } }
#pragma unroll
    for (int d0 = 0; d0 < 8; ++d0) { u32x4 w = {cvt_pk_bf16(y[d0][0], y[d0][1]), cvt_pk_bf16(y[d0][2], y[d0][3]), cvt_pk_bf16(y[d0][4], y[d0][5]), cvt_pk_bf16(y[d0][6], y[d0][7])};
      qr[d0] = *reinterpret_cast<bf16x8*>(&w); }
  }
  const int vrb = (int)(uintptr_t)(lds + LDS_VR) + v_rd_base(lane);
#define RESC(a) do { if (__any((a) < 1.f)) { if (hi == 0) al_l[r32] = (a); asm volatile("s_waitcnt lgkmcnt(0)" ::: "memory"); \
    _Pragma("unroll") for (int d = 0; d < 4; ++d) _Pragma("unroll") for (int r = 0; r < 16; ++r) o[d][r] *= al_l[crow(r, hi)]; } } while (0)
#define NEXT_SLOT(s) ((s) == 2 ? 0 : (s) + 1)
  f32x16 pA0, pA1, pB0, pB1; float mnA, mnB, alA, alB; bf16x8 pa0, pa1, pa2, pa3;
  TILE_BAR();
  DMA_TILE(1, 1);
  qkt_l(pA0, pA1, lds + LDS_KR, qr, r32, hi); partialSM(pA0, pA1, m_reg, mnA, alA);
  int sk = 1, sv = 0;
  for (int j = 1; j + 1 < NT; j += 2) {
    TILE_BAR(); { const int sn = NEXT_SLOT(sk); DMA_TILE(j + 1, sn); }
    SBAR(); qkt_l(pB0, pB1, lds + LDS_KR + sk * RSLOT, qr, r32, hi);
    finishSM(pA0, pA1, alA, l_reg, pa0, pa1, pa2, pa3); SBAR();
    pv_d0(o, vrb + sv * RSLOT, pa0, pa1, pa2, pa3); partialSM(pB0, pB1, m_reg, mnB, alB);
    RESC(alB);
    sv = sk; sk = NEXT_SLOT(sk);
    TILE_BAR(); if (j + 2 < NT) { const int sn = NEXT_SLOT(sk); DMA_TILE(j + 2, sn); }
    SBAR(); qkt_l(pA0, pA1, lds + LDS_KR + sk * RSLOT, qr, r32, hi);
    finishSM(pB0, pB1, alB, l_reg, pa0, pa1, pa2, pa3); SBAR();
    pv_d0(o, vrb + sv * RSLOT, pa0, pa1, pa2, pa3); partialSM(pA0, pA1, m_reg, mnA, alA);
    RESC(alA);
    sv = sk; sk = NEXT_SLOT(sk);
  }
  TILE_BAR();
  SBAR(); qkt_l(pB0, pB1, lds + LDS_KR + sk * RSLOT, qr, r32, hi);
  finishSM(pA0, pA1, alA, l_reg, pa0, pa1, pa2, pa3); SBAR();
  pv_d0(o, vrb + sv * RSLOT, pa0, pa1, pa2, pa3); partialSM(pB0, pB1, m_reg, mnB, alB);
  RESC(alB);
  finishSM(pB0, pB1, alB, l_reg, pa0, pa1, pa2, pa3); SBAR();
  pv_d0(o, vrb + sk * RSLOT, pa0, pa1, pa2, pa3);
  if (hi == 0) li_l[r32] = l_reg; asm volatile("s_waitcnt lgkmcnt(0)" ::: "memory");
  float rli[16];
#pragma unroll
  for (int r = 0; r < 16; ++r) rli[r] = __builtin_amdgcn_rcpf(li_l[crow(r, hi)]);
  bf16_t* Ow = Ob + (long)(wid * QBLK) * LDO;
#pragma unroll
  for (int r = 0; r < 16; ++r) { int orow = crow(r, hi);
#pragma unroll
    for (int d0 = 0; d0 < 4; ++d0) Ow[(long)orow * LDO + d0 * 32 + r32] = (bf16_t)(cvt_pk_bf16(o[d0][r] * rli[r], 0.f) & 0xffffu); }
#undef DMA_TILE
#undef DMA_PIECE
#undef TILE_BAR
#undef RESC
#undef NEXT_SLOT
}

__device__ __forceinline__ int krow(int kappa) { const int r = (kappa & 7) | ((kappa & 16) >> 1), hi = (kappa >> 3) & 1; return (r & 3) + 8 * (r >> 2) + 4 * hi; }
__device__ __forceinline__ void expA(f32x16& p0) {
#pragma unroll
  for (int r = 0; r < 16; ++r) p0[r] = __builtin_amdgcn_exp2f(p0[r]);
}
__device__ __forceinline__ void expB_pack(f32x16& p0, f32x16& p1, float& l_reg, bf16x8& pa0, bf16x8& pa1, bf16x8& pa2, bf16x8& pa3) {
#pragma unroll
  for (int r = 0; r < 16; ++r) p1[r] = __builtin_amdgcn_exp2f(p1[r]);
  float ps = 0;
#pragma unroll
  for (int r = 0; r < 16; ++r) ps += p0[r];
#pragma unroll
  for (int r = 0; r < 16; ++r) ps += p1[r];
  l_reg += ps;
#define PK8(P, BASE, OUT) do { u32x4 w = {cvt_pk_bf16(P[BASE + 0], P[BASE + 1]), cvt_pk_bf16(P[BASE + 2], P[BASE + 3]), cvt_pk_bf16(P[BASE + 4], P[BASE + 5]), cvt_pk_bf16(P[BASE + 6], P[BASE + 7])}; \
    OUT = *reinterpret_cast<bf16x8*>(&w); } while (0)
  PK8(p0, 0, pa0); PK8(p0, 8, pa1); PK8(p1, 0, pa2); PK8(p1, 8, pa3);
#undef PK8
}
__device__ __forceinline__ void attn_body_maxfree(const bf16_t* __restrict__ Qb, const char* __restrict__ Kt, const char* __restrict__ Vt, bf16_t* __restrict__ Ob, int NT, LAS unsigned char* lds,
                                                  const float* __restrict__ qn, const f32x2* __restrict__ rope_row, const f32x2* __restrict__ rope_col, int pos0) {
  int tid = threadIdx.x; asm volatile("" : "+v"(tid));
  const int wid = __builtin_amdgcn_readfirstlane(tid >> 6), lane = tid & 63, r32 = lane & 31, hi = lane >> 5;
  LAS float* li_l = (LAS float*)(lds + LDS_WS2) + wid * 64;
  const unsigned dma_l = (unsigned)wid * 1024u;
  const unsigned dma_v = dma_l + (unsigned)lane * 16u;
  const unsigned ldsb = (unsigned)(uintptr_t)lds + dma_l;
#define DMA_PIECE(goff, gbase, ldst) do { asm volatile("s_mov_b32 m0, %2\n\ts_nop 0\n\tglobal_load_lds_dwordx4 %0, %1" :: "v"(goff), "s"(gbase), "s"(ldst) : "memory"); } while (0)
#define DMA_TILE(t, s) do { _Pragma("unroll") for (int _i = 0; _i < 2; ++_i) { \
    DMA_PIECE(dma_v + _i * 8192, Kt + (size_t)(t) * RSLOT, ldsb + (unsigned)(LDS_KR + (s) * RSLOT + _i * 8192)); \
    DMA_PIECE(dma_v + _i * 8192, Vt + (size_t)(t) * RSLOT, ldsb + (unsigned)(LDS_VR + (s) * RSLOT + _i * 8192)); } } while (0)
#define TILE_BAR() do { asm volatile("s_waitcnt vmcnt(0)" ::: "memory"); __builtin_amdgcn_s_barrier(); asm volatile("" ::: "memory"); } while (0)
  DMA_TILE(0, 0);
  float l_reg = 0; f32x16 o[4] = {}; bf16x8 qr[8];
  const bf16_t* Qw = Qb + (long)(wid * QBLK + r32) * LDQ + hi * 8;
  {
    u32x4 raw[8];
#pragma unroll
    for (int d0 = 0; d0 < 8; ++d0) raw[d0] = *reinterpret_cast<const u32x4*>(Qw + d0 * 16);
    float y[8][8]; float ss = 0.f;
#pragma unroll
    for (int d0 = 0; d0 < 8; ++d0)
#pragma unroll
      for (int j = 0; j < 4; ++j) { y[d0][2 * j] = bf_lo(raw[d0][j]); y[d0][2 * j + 1] = bf_hi(raw[d0][j]); ss += y[d0][2 * j] * y[d0][2 * j] + y[d0][2 * j + 1] * y[d0][2 * j + 1]; }
    ss = xor32_sum(ss);
    const float rstd = (SCALE * 1.4426950408889634f) / sqrtf(ss * (1.0f / 128.0f) + EPS);
#pragma unroll
    for (int d0 = 0; d0 < 8; ++d0) { const f32x4 g0 = *(const f32x4*)(qn + d0 * 16 + hi * 8), g1 = *(const f32x4*)(qn + d0 * 16 + hi * 8 + 4);
#pragma unroll
      for (int j = 0; j < 4; ++j) { y[d0][j] *= rstd * g0[j]; y[d0][4 + j] *= rstd * g1[j]; } }
    const int pos = pos0 + wid * QBLK + r32;
#pragma unroll
    for (int blk = 0; blk < 2; ++blk) { const f32x2* tab = blk ? (rope_col + (pos & 63) * 32) : (rope_row + (pos >> 6) * 32);
#pragma unroll
      for (int dd = 0; dd < 2; ++dd) { const f32x4* tp = (const f32x4*)(tab + dd * 16 + hi * 8); const int da = 4 * blk + dd, db = da + 2;
#pragma unroll
        for (int j2 = 0; j2 < 4; ++j2) { const f32x4 cs = tp[j2];
          { const float x1 = y[da][2 * j2], x2 = y[db][2 * j2]; y[da][2 * j2] = x1 * cs[0] - x2 * cs[1]; y[db][2 * j2] = x2 * cs[0] + x1 * cs[1]; }
          { const float x1 = y[da][2 * j2 + 1], x2 = y[db][2 * j2 + 1]; y[da][2 * j2 + 1] = x1 * cs[2] - x2 * cs[3]; y[db][2 * j2 + 1] = x2 * cs[2] + x1 * cs[3]; } } } }
#pragma unroll
    for (int d0 = 0; d0 < 8; ++d0) { u32x4 w = {cvt_pk_bf16(y[d0][0], y[d0][1]), cvt_pk_bf16(y[d0][2], y[d0][3]), cvt_pk_bf16(y[d0][4], y[d0][5]), cvt_pk_bf16(y[d0][6], y[d0][7])};
      qr[d0] = *reinterpret_cast<bf16x8*>(&w); }
  }
  const int vrb = (int)(uintptr_t)(lds + LDS_VR) + v_rd_base(lane);
#define NEXT_SLOT(s) ((s) == 2 ? 0 : (s) + 1)
  f32x16 pA0, pA1, pB0, pB1; bf16x8 pa0, pa1, pa2, pa3;
  if (wid >= 4) __builtin_amdgcn_s_setprio(1);
  TILE_BAR();
  DMA_TILE(1, 1);
  qkt_l(pA0, pA1, lds + LDS_KR, qr, r32, hi); expA(pA0);
  int sk = 1, sv = 0;
  for (int j = 1; j + 1 < NT; j += 2) {
    TILE_BAR(); { const int sn = NEXT_SLOT(sk); DMA_TILE(j + 1, sn); }
    SBAR(); qkt_l(pB0, pB1, lds + LDS_KR + sk * RSLOT, qr, r32, hi);
    expB_pack(pA0, pA1, l_reg, pa0, pa1, pa2, pa3); SBAR();
    pv_d0(o, vrb + sv * RSLOT, pa0, pa1, pa2, pa3); expA(pB0);
    sv = sk; sk = NEXT_SLOT(sk);
    TILE_BAR(); if (j + 2 < NT) { const int sn = NEXT_SLOT(sk); DMA_TILE(j + 2, sn); }
    SBAR(); qkt_l(pA0, pA1, lds + LDS_KR + sk * RSLOT, qr, r32, hi);
    expB_pack(pB0, pB1, l_reg, pa0, pa1, pa2, pa3); SBAR();
    pv_d0(o, vrb + sv * RSLOT, pa0, pa1, pa2, pa3); expA(pA0);
    sv = sk; sk = NEXT_SLOT(sk);
  }
  TILE_BAR();
  SBAR(); qkt_l(pB0, pB1, lds + LDS_KR + sk * RSLOT, qr, r32, hi);
  expB_pack(pA0, pA1, l_reg, pa0, pa1, pa2, pa3); SBAR();
  pv_d0(o, vrb + sv * RSLOT, pa0, pa1, pa2, pa3); expA(pB0);
  expB_pack(pB0, pB1, l_reg, pa0, pa1, pa2, pa3); SBAR();
  pv_d0(o, vrb + sk * RSLOT, pa0, pa1, pa2, pa3);
  __builtin_amdgcn_s_setprio(0);
  l_reg = xor32_sum(l_reg);
  if (hi == 0) li_l[r32] = l_reg; asm volatile("s_waitcnt lgkmcnt(0)" ::: "memory");
  float rli[16];
#pragma unroll
  for (int r = 0; r < 16; ++r) rli[r] = __builtin_amdgcn_rcpf(li_l[crow(r, hi)]);
  bf16_t* Ow = Ob + (long)(wid * QBLK) * LDO;
#pragma unroll
  for (int r = 0; r < 16; ++r) { int orow = crow(r, hi);
#pragma unroll
    for (int d0 = 0; d0 < 4; ++d0) Ow[(long)orow * LDO + d0 * 32 + r32] = (bf16_t)(cvt_pk_bf16(o[d0][r] * rli[r], 0.f) & 0xffffu); }
#undef DMA_TILE
#undef DMA_PIECE
#undef TILE_BAR
#undef NEXT_SLOT
}
}

struct Args {
    const float* x_prompt; const float* x_sample; const float* norm_mix; const float* w_in; const float* gate_bias; const float* conv_w; const float* sgu_ln; const float* sgu_ws;
    const float* sgu_b; const float* q_norm; const float* k_norm; const float* w_br_conv; const float* w_br_sgu; const float* w_br_attn; const float* w_out; const float* norm_ffn;
    const float* w_ffn_in; const float* w_ffn_out; const float* norm_final; float* out; unsigned char* ws;
};
#define GASQ __attribute__((address_space(1)))
struct ArgsD {
    const GASQ float* x_prompt; const GASQ float* x_sample; const GASQ float* norm_mix; const GASQ float* w_in; const GASQ float* gate_bias; const GASQ float* conv_w; const GASQ float* sgu_ln; const GASQ float* sgu_ws;
    const GASQ float* sgu_b; const GASQ float* q_norm; const GASQ float* k_norm; const GASQ float* w_br_conv; const GASQ float* w_br_sgu; const GASQ float* w_br_attn; const GASQ float* w_out; const GASQ float* norm_ffn;
    const GASQ float* w_ffn_in; const GASQ float* w_ffn_out; const GASQ float* norm_final; GASQ float* out; GASQ unsigned char* ws;
};
static_assert(sizeof(ArgsD) == sizeof(Args), "ArgsD mirrors Args");
#define ARG(f) ((decltype(Args::f))(a->f))
typedef const __attribute__((address_space(4))) ArgsD* KArgs;
__device__ __forceinline__ KArgs kargs() { KArgs p = (KArgs)__builtin_amdgcn_kernarg_segment_ptr(); asm volatile("" : "+s"(p)); return p; }
__device__ __forceinline__ int opaque_tid() { int t = threadIdx.x; asm volatile("" : "+v"(t)); return t; }

__device__ __forceinline__ void transpose_item(const float* W, int ldw, int scol0, int k0, bf16_t* dst, int ldk, LAS float* scr, int lane, const float* gain) {
#pragma unroll 8
    for (int i = 0; i < 32; ++i) { const int kk = 2 * i + (lane >> 5); const float gk = gain ? gain[k0 + kk] : 1.0f; scr[kk * 33 + (lane & 31)] = W[(size_t)(k0 + kk) * ldw + scol0 + (lane & 31)] * gk; }
    LDS_WAIT(); asm volatile("" ::: "memory");
    const int c = lane & 7;
#pragma unroll
    for (int j = 0; j < 4; ++j) { const int n = (lane >> 3) + 8 * j; const LAS float* s = scr + (8 * c) * 33 + n;
        u32x4 o; o.x = cvt_pk_bf16(s[0 * 33], s[1 * 33]); o.y = cvt_pk_bf16(s[2 * 33], s[3 * 33]); o.z = cvt_pk_bf16(s[4 * 33], s[5 * 33]); o.w = cvt_pk_bf16(s[6 * 33], s[7 * 33]);
        *(u32x4*)(dst + (size_t)n * ldk + 8 * c) = o; }
    LDS_WAIT(); asm volatile("" ::: "memory");
}

__device__ __forceinline__ void sincos_d(double a, double& s, double& c) {
    const double k = __builtin_rint(a * 0.63661977236758134308);
    double r = a - k * 1.57079632673412561417e+00; r = r - k * 6.07710050650619224932e-11;
    const double r2 = r * r;
    double sp = -1.0 / 1307674368000.0; sp = sp * r2 + 1.0 / 6227020800.0; sp = sp * r2 - 1.0 / 39916800.0; sp = sp * r2 + 1.0 / 362880.0; sp = sp * r2 - 1.0 / 5040.0; sp = sp * r2 + 1.0 / 120.0; sp = sp * r2 - 1.0 / 6.0; sp = sp * r2 + 1.0;
    const double sn = r * sp;
    double cp = 1.0 / 20922789888000.0; cp = cp * r2 - 1.0 / 87178291200.0; cp = cp * r2 + 1.0 / 479001600.0; cp = cp * r2 - 1.0 / 3628800.0; cp = cp * r2 + 1.0 / 40320.0; cp = cp * r2 - 1.0 / 720.0; cp = cp * r2 + 1.0 / 24.0; cp = cp * r2 - 0.5; cp = cp * r2 + 1.0;
    const int q = ((int)k) & 3;
    s = (q == 0) ? sn : (q == 1) ? cp : (q == 2) ? -sn : -cp;
    c = (q == 0) ? cp : (q == 1) ? -sn : (q == 2) ? -cp : sn;
}

__device__ __forceinline__ void phase_prologue(LAS unsigned char* lds) {
    KArgs a = kargs(); const int tid = opaque_tid(), lane = tid & 63, wave = __builtin_amdgcn_readfirstlane(tid >> 6);
    const int G = gridDim.x, bx = blockIdx.x, gw = bx * 8 + wave, NGW = G * 8;
    unsigned char* ws = ARG(ws);
    bf16_t* Win_t = (bf16_t*)(ws + WS_WIN); bf16_t* Wbr_t = (bf16_t*)(ws + WS_WBR); bf16_t* Wout_t = (bf16_t*)(ws + WS_WOUT); bf16_t* Wfi_t = (bf16_t*)(ws + WS_WFI); bf16_t* Wfo_t = (bf16_t*)(ws + WS_WFO);
    LAS float* scr = (LAS float*)(lds + wave * 9216);
    constexpr int I_IN = 32 * 448, I_BC = 16 * 64, I_BA = 32 * 64, I_O = 32 * 64, I_FI = 32 * 352, I_FO = 88 * 64;
    constexpr int PER_LAYER = I_IN + 2 * I_BC + I_BA + I_O + I_FI + I_FO, TOTAL = DEPTH * PER_LAYER;
    struct TItem { const float* src; bf16_t* dst; const float* gain; int ldw, ldk; };
    auto titem = [&](int it) -> TItem {
        const int layer = it / PER_LAYER; int r = it - layer * PER_LAYER; TItem t;
        if (r < I_IN) { const int kb = r / 448, nb = r % 448, k0 = 64 * kb, n0 = 32 * nb;
            t.src = ARG(w_in) + (size_t)layer * DM * DIN + (size_t)k0 * DIN + n0; t.ldw = DIN; t.dst = Win_t + (size_t)layer * DIN * DM + (size_t)n0 * DM + k0; t.ldk = DM; t.gain = ARG(norm_mix) + layer * DM + k0; return t; }
        r -= I_IN;
        if (r < I_BC) { const int kb = r / 64, nb = r % 64, k0 = 64 * kb, n0 = 32 * nb;
            t.src = ARG(w_br_conv) + (size_t)layer * 1024 * DM + (size_t)k0 * DM + n0; t.ldw = DM; t.dst = Wbr_t + (size_t)layer * DM * MIXW + (size_t)n0 * MIXW + k0; t.ldk = MIXW; t.gain = nullptr; return t; }
        r -= I_BC;
        if (r < I_BC) { const int kb = r / 64, nb = r % 64, k0 = 64 * kb, n0 = 32 * nb;
            t.src = ARG(w_br_sgu) + (size_t)layer * 1024 * DM + (size_t)k0 * DM + n0; t.ldw = DM; t.dst = Wbr_t + (size_t)layer * DM * MIXW + (size_t)n0 * MIXW + 1024 + k0; t.ldk = MIXW; t.gain = nullptr; return t; }
        r -= I_BC;
        if (r < I_BA) { const int kb = r / 64, nb = r % 64, k0 = 64 * kb, n0 = 32 * nb;
            t.src = ARG(w_br_attn) + (size_t)layer * DM * DM + (size_t)k0 * DM + n0; t.ldw = DM; t.dst = Wbr_t + (size_t)layer * DM * MIXW + (size_t)n0 * MIXW + 2048 + k0; t.ldk = MIXW; t.gain = nullptr; return t; }
        r -= I_BA;
        if (r < I_O) { const int kb = r / 64, nb = r % 64, k0 = 64 * kb, n0 = 32 * nb;
            t.src = ARG(w_out) + (size_t)layer * DM * DM + (size_t)k0 * DM + n0; t.ldw = DM; t.dst = Wout_t + (size_t)layer * DM * DM + (size_t)n0 * DM + k0; t.ldk = DM; t.gain = nullptr; return t; }
        r -= I_O;
        if (r < I_FI) { const int kb = r / 352, nb = r % 352, k0 = 64 * kb, n0 = 32 * nb, tile = n0 >> 8, w = n0 & 255;
            const int scol0 = (w < 128) ? (128 * tile + w) : (DFF + 128 * tile + (w - 128));
            t.src = ARG(w_ffn_in) + (size_t)layer * DM * NFF2 + (size_t)k0 * NFF2 + scol0; t.ldw = NFF2; t.dst = Wfi_t + (size_t)layer * NFF2 * DM + (size_t)n0 * DM + k0; t.ldk = DM; t.gain = ARG(norm_ffn) + layer * DM + k0; return t; }
        r -= I_FI;
        { const int kb = r / 64, nb = r % 64, k0 = 64 * kb, n0 = 32 * nb;
            t.src = ARG(w_ffn_out) + (size_t)layer * DFF * DM + (size_t)k0 * DM + n0; t.ldw = DM; t.dst = Wfo_t + (size_t)layer * DM * DFF + (size_t)n0 * DFF + k0; t.ldk = DFF; t.gain = nullptr; return t; }
    };
    const float* ones_or_any = ARG(norm_final);
    const int lr = lane >> 3, lc = (lane & 7) * 4;
    if (gw < TOTAL) {
        TItem cur = titem(gw); f32x4 v[8]; float gv[8];
#pragma unroll
        for (int i = 0; i < 8; ++i) { v[i] = *(const f32x4*)(cur.src + (size_t)(8 * i + lr) * cur.ldw + lc); gv[i] = (cur.gain ? cur.gain : ones_or_any)[8 * i + lr]; }
        for (int it = gw; it < TOTAL; it += NGW) {
            const int nit = (it + NGW < TOTAL) ? it + NGW : it;
            const TItem nx = titem(nit); f32x4 nv[8]; float ng[8];
#pragma unroll
            for (int i = 0; i < 8; ++i) { nv[i] = *(const f32x4*)(nx.src + (size_t)(8 * i + lr) * nx.ldw + lc); ng[i] = (nx.gain ? nx.gain : ones_or_any)[8 * i + lr]; }
            const bool hg = cur.gain != nullptr;
#pragma unroll
            for (int i = 0; i < 8; ++i) { const float g = hg ? gv[i] : 1.0f; *(LAS f32x4*)(scr + (8 * i + lr) * 36 + lc) = v[i] * g; }
            LDS_WAIT(); asm volatile("" ::: "memory");
            { const int n = lane & 31, g2 = lane >> 5;
#pragma unroll
              for (int j = 0; j < 4; ++j) { const int c = g2 + 2 * j; const LAS float* sp = scr + (8 * c) * 36 + n;
                  u32x4 o; o.x = cvt_pk_bf16(sp[0 * 36], sp[1 * 36]); o.y = cvt_pk_bf16(sp[2 * 36], sp[3 * 36]); o.z = cvt_pk_bf16(sp[4 * 36], sp[5 * 36]); o.w = cvt_pk_bf16(sp[6 * 36], sp[7 * 36]);
                  *(u32x4*)(cur.dst + (size_t)n * cur.ldk + 8 * c) = o; } }
            LDS_WAIT(); asm volatile("" ::: "memory");
            cur = nx;
#pragma unroll
            for (int i = 0; i < 8; ++i) { v[i] = nv[i]; gv[i] = ng[i]; }
        }
    }
    const int gt = bx * 512 + tid, NT = G * 512;
    unsigned* SGUWb = (unsigned*)(ws + WS_SGUW); const f32x2* sw = (const f32x2*)ARG(sgu_ws);
    for (int i = gt; i < DEPTH * 8 * 128 * 128 / 2; i += NT) { const f32x2 v = sw[i]; SGUWb[i] = cvt_pk_bf16(v.x, v.y); }
    { bf16_t* XBA = (bf16_t*)(ws + WS_XBA); unsigned* SS = (unsigned*)(ws + WS_SS);
      for (int m = gw; m < NTOK; m += NGW) { const float* xrow = (m < 2 * TG) ? ARG(x_prompt) + (size_t)m * DM : ARG(x_sample) + (size_t)(m - 2 * TG) * DM;
          const f32x4* xr = (const f32x4*)xrow + lane; f32x4 v[8]; float sq = 0.f;
#pragma unroll
          for (int j = 0; j < 8; ++j) { v[j] = xr[64 * j]; sq += (v[j].x * v[j].x + v[j].y * v[j].y) + (v[j].z * v[j].z + v[j].w * v[j].w); }
          sq = wave_sum(sq);
          u32x2* o8 = (u32x2*)(XBA + (size_t)m * DM) + lane;
#pragma unroll
          for (int j = 0; j < 8; ++j) { u32x2 w; w.x = cvt_pk_bf16(v[j].x, v[j].y); w.y = cvt_pk_bf16(v[j].z, v[j].w); o8[64 * j] = w; }
          if (lane == 0) SS[m] = (unsigned)(sq * SS_SCALE + 0.5f); } }
    f32x2* rope = (f32x2*)(ws + WS_ROPE);
    for (int i = gt; i < 192 * 32; i += NT) { const int pos = i >> 5, f = i & 31;
        double inv = 1.0; for (int j = 0; j < f; ++j) inv *= 0.7498942093324559;
        const double ang = (double)(pos < 128 ? pos : pos - 128) * inv; double s, c; sincos_d(ang, s, c);
        rope[i] = (f32x2){(float)c, (float)s}; }
}

__device__ __forceinline__ void phase_sgu(int layer, LAS unsigned char* lds) {
    KArgs a = kargs(); const int tid = opaque_tid(), lane = tid & 63, wave = __builtin_amdgcn_readfirstlane(tid >> 6);
    unsigned char* ws = ARG(ws); bf16_t* Zb = (bf16_t*)(ws + WS_Z); bf16_t* MIXb = (bf16_t*)(ws + WS_MIX); const bf16_t* SGUWb = (const bf16_t*)(ws + WS_SGUW);
    const float* sgu_ln = ARG(sgu_ln) + layer * 1024; const float* sgu_b = ARG(sgu_b) + layer * 1024;
    LAS float* ot = (LAS float*)(lds + 32768); LAS f32x2* stat = (LAS f32x2*)(lds + 102400);
    for (int item = blockIdx.x; item < 256; item += gridDim.x) {
        const int chunk = item >> 1, half = item & 1, R0 = chunk * 128;
#pragma unroll
        for (int bt = 0; bt < 2; ++bt) { u32x4 w0[8], w1[8];
#pragma unroll
            for (int i = 0; i < 8; ++i) { const bf16_t* p = Zb + (size_t)(R0 + wave * 16 + bt * 8 + i) * DIN + ZC_SV + lane * 16; w0[i] = *(const u32x4*)p; w1[i] = *(const u32x4*)(p + 8); }
            float s[8];
#pragma unroll
            for (int i = 0; i < 8; ++i) { float ac = 0.f;
#pragma unroll
                for (int j = 0; j < 4; ++j) ac += (bf_lo(w0[i][j]) + bf_hi(w0[i][j])) + (bf_lo(w1[i][j]) + bf_hi(w1[i][j]));
                s[i] = ac; }
#pragma unroll
            for (int i = 0; i < 8; ++i) s[i] = wave_sum(s[i]) * (1.0f / 1024.0f);
            float q[8];
#pragma unroll
            for (int i = 0; i < 8; ++i) { float ac = 0.f;
#pragma unroll
                for (int j = 0; j < 4; ++j) { const float d0 = bf_lo(w0[i][j]) - s[i], d1 = bf_hi(w0[i][j]) - s[i], d2 = bf_lo(w1[i][j]) - s[i], d3 = bf_hi(w1[i][j]) - s[i]; ac += (d0 * d0 + d1 * d1) + (d2 * d2 + d3 * d3); }
                q[i] = ac; }
#pragma unroll
            for (int i = 0; i < 8; ++i) q[i] = wave_sum(q[i]);
#pragma unroll
            for (int i = 0; i < 8; ++i) if (lane == i) stat[wave * 16 + bt * 8 + i] = (f32x2){s[i], 1.0f / sqrtf(q[i] * (1.0f / 1024.0f) + EPS)}; }
        LDS_WAIT(); __syncthreads();
        const int r32 = lane & 31, hi = lane >> 5, pb = wave & 3, dd = wave >> 2;
        for (int gi = 0; gi < 4; ++gi) { const int g = half * 4 + gi;
            u32x4 wv[4], wu[4];
#pragma unroll
            for (int i = 0; i < 4; ++i) { const int pid = tid + 512 * i, q = pid >> 4, c8 = (pid & 15) * 8; const bf16_t* zr = Zb + (size_t)(R0 + q) * DIN + g * 128 + c8;
                wv[i] = *(const u32x4*)(zr + ZC_SV); wu[i] = *(const u32x4*)(zr + ZC_SU); }
            const bf16_t* Wg = SGUWb + ((size_t)(layer * 8 + g) * 128 + 32 * pb + r32) * 128 + hi * 8;
            bf16x8 pa[2][4];
#pragma unroll
            for (int tl = 0; tl < 2; ++tl)
#pragma unroll
                for (int ks = 0; ks < 4; ++ks) pa[tl][ks] = *(const bf16x8*)(Wg + tl * 64 + ks * 16);
#pragma unroll
            for (int i = 0; i < 4; ++i) { const int pid = tid + 512 * i, q = pid >> 4, c8 = (pid & 15) * 8; const u32x4 w = wv[i]; const f32x2 st = stat[q];
                const f32x4 g0 = *(const f32x4*)(sgu_ln + g * 128 + c8), g1 = *(const f32x4*)(sgu_ln + g * 128 + c8 + 4);
                u32x4 o; o.x = cvt_pk_bf16((bf_lo(w.x) - st.x) * st.y * g0.x, (bf_hi(w.x) - st.x) * st.y * g0.y); o.y = cvt_pk_bf16((bf_lo(w.y) - st.x) * st.y * g0.z, (bf_hi(w.y) - st.x) * st.y * g0.w);
                o.z = cvt_pk_bf16((bf_lo(w.z) - st.x) * st.y * g1.x, (bf_hi(w.z) - st.x) * st.y * g1.y); o.w = cvt_pk_bf16((bf_lo(w.w) - st.x) * st.y * g1.z, (bf_hi(w.w) - st.x) * st.y * g1.w);
                *(LAS u32x4*)(lds + (q >> 6) * 16384 + att::v_st(q & 63, c8)) = o; }
            LDS_WAIT(); __syncthreads();
            f32x16 o0 = {}, o1 = {};
#pragma unroll
            for (int tl = 0; tl < 2; ++tl) { const int vb = (int)(uintptr_t)(lds + tl * 16384) + att::v_rd_base(lane) + dd * 1024;
                att::pv_one<0>(o0, vb, pa[tl][0], pa[tl][1], pa[tl][2], pa[tl][3]); att::pv_one<1>(o1, vb, pa[tl][0], pa[tl][1], pa[tl][2], pa[tl][3]); }
            const float* bs = sgu_b + g * 128 + 32 * pb;
#pragma unroll
            for (int r = 0; r < 16; ++r) { const int p = att::crow(r, hi); const float bias = bs[p]; LAS float* orow = ot + (32 * pb + p) * 132 + 64 * dd + r32;
                orow[0] = o0[r] + bias; orow[32] = o1[r] + bias; }
            LDS_WAIT(); __syncthreads();
#pragma unroll
            for (int i = 0; i < 4; ++i) { const int pid = tid + 512 * i, q = pid >> 4, c8 = (pid & 15) * 8; const u32x4 u = wu[i];
                const f32x4 m0 = *(const LAS f32x4*)(ot + q * 132 + c8), m1 = *(const LAS f32x4*)(ot + q * 132 + c8 + 4);
                u32x4 o; o.x = cvt_pk_bf16(bf_lo(u.x) * m0[0], bf_hi(u.x) * m0[1]); o.y = cvt_pk_bf16(bf_lo(u.y) * m0[2], bf_hi(u.y) * m0[3]);
                o.z = cvt_pk_bf16(bf_lo(u.z) * m1[0], bf_hi(u.z) * m1[1]); o.w = cvt_pk_bf16(bf_lo(u.w) * m1[2], bf_hi(u.w) * m1[3]);
                *(u32x4*)(MIXb + (size_t)(R0 + q) * MIXW + 1024 + g * 128 + c8) = o; }
            LDS_WAIT(); __syncthreads(); }
    }
}

__device__ __forceinline__ void phase_conv_k(int layer, int grp) {
    KArgs a = kargs(); const int tid = opaque_tid(), lane = tid & 63, wave = __builtin_amdgcn_readfirstlane(tid >> 6);
    const int gw = blockIdx.x * 8 + wave, NGW = gridDim.x * 8;
    unsigned char* ws = ARG(ws); bf16_t* Zb = (bf16_t*)(ws + WS_Z); bf16_t* MIXb = (bf16_t*)(ws + WS_MIX);
    const f32x2* rope_row = (const f32x2*)(ws + WS_ROPE); const f32x2* rope_col = rope_row + 128 * 32; char* KT = (char*)(ws + WS_KT); char* VT = (char*)(ws + WS_VT);
    const float* conv_w = ARG(conv_w) + (size_t)layer * 3 * 1024; const float* k_norm = ARG(k_norm) + layer * 128;
    { unsigned* SS = (unsigned*)(ws + WS_SS);
      for (int i = blockIdx.x * 512 + tid; i < TG; i += gridDim.x * 512) { __hip_atomic_store(SS + (size_t)grp * TG + i, 0u, __ATOMIC_RELAXED, __HIP_MEMORY_SCOPE_AGENT); __hip_atomic_store(SS + (size_t)3 * TG + i, 0u, __ATOMIC_RELAXED, __HIP_MEMORY_SCOPE_AGENT); } }
    for (int item = gw; item < (TG / 4) * 2; item += NGW) { const int blk = item >> 1, hf = item & 1, t0 = blk * 4, s0 = t0 & (SEQ - 1), c0 = hf * 512 + lane * 8;
        u32x4 cc[6], cx[6], cb[4];
#pragma unroll
        for (int i = 0; i < 6; ++i) { int row = t0 - 1 + i; row = (i == 0 && s0 == 0) ? t0 : row; row = (i == 5 && s0 == SEQ - 4) ? t0 + 3 : row;
            cc[i] = *(const u32x4*)(Zb + (size_t)row * DIN + ZC_CC + c0); cx[i] = *(const u32x4*)(Zb + (size_t)row * DIN + ZC_CX + c0); }
#pragma unroll
        for (int i = 0; i < 4; ++i) cb[i] = *(const u32x4*)(Zb + (size_t)(t0 + i) * DIN + ZC_CB + c0);
        const f32x4 wa0 = *(const f32x4*)(conv_w + c0), wa1 = *(const f32x4*)(conv_w + c0 + 4), wb0 = *(const f32x4*)(conv_w + 1024 + c0), wb1 = *(const f32x4*)(conv_w + 1024 + c0 + 4),
                    wc0 = *(const f32x4*)(conv_w + 2048 + c0), wc1 = *(const f32x4*)(conv_w + 2048 + c0 + 4);
        const float m0 = (s0 == 0) ? 0.f : 1.f, m5 = (s0 == SEQ - 4) ? 0.f : 1.f;
        float h[6][8];
#pragma unroll
        for (int i = 0; i < 6; ++i) { const float mk = (i == 0) ? m0 : (i == 5) ? m5 : 1.f;
#pragma unroll
            for (int j = 0; j < 4; ++j) { h[i][2 * j] = bf_lo(cc[i][j]) * bf_lo(cx[i][j]) * mk; h[i][2 * j + 1] = bf_hi(cc[i][j]) * bf_hi(cx[i][j]) * mk; } }
#pragma unroll
        for (int i = 0; i < 4; ++i) { float y[8];
#pragma unroll
            for (int j = 0; j < 4; ++j) { y[j] = wa0[j] * h[i][j] + wb0[j] * h[i + 1][j] + wc0[j] * h[i + 2][j]; y[4 + j] = wa1[j] * h[i][4 + j] + wb1[j] * h[i + 1][4 + j] + wc1[j] * h[i + 2][4 + j]; }
            u32x4 o; o.x = cvt_pk_bf16(bf_lo(cb[i].x) * y[0], bf_hi(cb[i].x) * y[1]); o.y = cvt_pk_bf16(bf_lo(cb[i].y) * y[2], bf_hi(cb[i].y) * y[3]);
            o.z = cvt_pk_bf16(bf_lo(cb[i].z) * y[4], bf_hi(cb[i].z) * y[5]); o.w = cvt_pk_bf16(bf_lo(cb[i].w) * y[6], bf_hi(cb[i].w) * y[7]);
            *(u32x4*)(MIXb + (size_t)(t0 + i) * MIXW + c0) = o; }
    }
    const int l16 = lane & 15; const bool first = (l16 & 4) == 0;
    const f32x4 kn0 = *(const f32x4*)(k_norm + l16 * 8), kn1 = *(const f32x4*)(k_norm + l16 * 8 + 4);
    for (int blk = gw; blk < TG / 4; blk += NGW) { const int t0 = blk * 4, s0 = t0 & (SEQ - 1);
        u32x4 kx[4], vx[4]; f32x4 cs[4][4];
#pragma unroll
        for (int i = 0; i < 4; ++i) { kx[i] = *(const u32x4*)(Zb + (size_t)(t0 + i) * DIN + ZC_K + lane * 8); vx[i] = *(const u32x4*)(Zb + (size_t)(t0 + i) * DIN + ZC_V + lane * 8); const int pos = s0 + i;
            const f32x4* tab = (const f32x4*)((l16 < 8) ? (rope_row + (pos >> 6) * 32 + (l16 & 3) * 8) : (rope_col + (pos & 63) * 32 + (l16 & 3) * 8));
#pragma unroll
            for (int j = 0; j < 4; ++j) cs[i][j] = tab[j]; }
#pragma unroll
        for (int i = 0; i < 4; ++i) { float x[8];
#pragma unroll
            for (int j = 0; j < 4; ++j) { x[2 * j] = bf_lo(kx[i][j]); x[2 * j + 1] = bf_hi(kx[i][j]); }
            float ss = 0.f;
#pragma unroll
            for (int j = 0; j < 8; ++j) ss += x[j] * x[j];
            ss += swz_xor<1>(ss); ss += swz_xor<2>(ss); ss += swz_xor<4>(ss); ss += swz_xor<8>(ss);
            const float rstd = 1.0f / sqrtf(ss * (1.0f / 128.0f) + EPS);
            float y[8], o[8];
#pragma unroll
            for (int j = 0; j < 4; ++j) { y[j] = x[j] * rstd * kn0[j]; y[4 + j] = x[4 + j] * rstd * kn1[j]; }
#pragma unroll
            for (int j = 0; j < 8; ++j) { const float py = swz_xor<4>(y[j]); const float c = cs[i][j >> 1][(j & 1) * 2], s = cs[i][j >> 1][(j & 1) * 2 + 1];
                o[j] = first ? (y[j] * c - py * s) : (y[j] * c + py * s); }
            u32x4 ow; ow.x = cvt_pk_bf16(o[0], o[1]); ow.y = cvt_pk_bf16(o[2], o[3]); ow.z = cvt_pk_bf16(o[4], o[5]); ow.w = cvt_pk_bf16(o[6], o[7]);
            const int t = t0 + i, bb = t >> 13, sp = t & (SEQ - 1), r = sp & 63; const size_t img = (size_t)((bb * NKV + (lane >> 4)) * 128 + (sp >> 6)) * 16384;
            const int rk = (r & 32) | att::krow(r & 31);
            *(u32x4*)(KT + img + KSWZ(rk, l16 * 16)) = ow;
            *(u32x4*)(VT + img + att::v_st(r, l16 * 8)) = vx[i]; }
    }
}

__device__ __forceinline__ void phase_attention(int layer, LAS unsigned char* lds) {
    KArgs a = kargs(); unsigned char* ws = ARG(ws); const bf16_t* Zb = (const bf16_t*)(ws + WS_Z); bf16_t* MIXb = (bf16_t*)(ws + WS_MIX);
    const f32x2* rope_row = (const f32x2*)(ws + WS_ROPE); const f32x2* rope_col = rope_row + 128 * 32; const float* qn = ARG(q_norm) + layer * 128;
    const char* KT = (const char*)(ws + WS_KT); const char* VT = (const char*)(ws + WS_VT);
    bool maxfree;
    { const int lane = opaque_tid() & 63; const float* kn = ARG(k_norm) + layer * 128;
      float gq = fmaxf(fabsf(qn[lane]), fabsf(qn[lane + 64])), gk = fmaxf(fabsf(kn[lane]), fabsf(kn[lane + 64]));
      gq = fmaxf(gq, swz_xor<1>(gq)); gq = fmaxf(gq, swz_xor<2>(gq)); gq = fmaxf(gq, swz_xor<4>(gq)); gq = fmaxf(gq, swz_xor<8>(gq)); gq = fmaxf(gq, swz_xor<16>(gq));
      gk = fmaxf(gk, swz_xor<1>(gk)); gk = fmaxf(gk, swz_xor<2>(gk)); gk = fmaxf(gk, swz_xor<4>(gk)); gk = fmaxf(gk, swz_xor<8>(gk)); gk = fmaxf(gk, swz_xor<16>(gk));
      { auto r = __builtin_amdgcn_permlane32_swap(__float_as_uint(gq), __float_as_uint(gq), false, false); gq = fmaxf(__uint_as_float(r[0]), __uint_as_float(r[1])); }
      { auto r = __builtin_amdgcn_permlane32_swap(__float_as_uint(gk), __float_as_uint(gk), false, false); gk = fmaxf(__uint_as_float(r[0]), __uint_as_float(r[1])); }
      const float bound = att::SCALE * 1.4426950408889634f * 128.0f * gq * gk;
      maxfree = __builtin_amdgcn_readfirstlane(bound < 100.0f ? 1 : 0) != 0; }
    for (int u = blockIdx.x; u < 1024; u += gridDim.x) { const int i = u >> 8, cc = u & 255, pair = cc & 7, qb = cc >> 3, b = pair >> 2, kvh = pair & 3, h = kvh * 4 + i;
        const size_t img = (size_t)((b * NKV + kvh) * 128) * 16384;
        if (maxfree) att::attn_body_maxfree(Zb + ((size_t)b * SEQ + (size_t)qb * 256) * DIN + ZC_Q + h * HD, KT + img, VT + img,
                                 MIXb + ((size_t)b * SEQ + (size_t)qb * 256) * MIXW + 2048 + h * HD, SEQ / 64, lds, qn, rope_row, rope_col, qb * 256);
        else att::attn_dense_body_dma(Zb + ((size_t)b * SEQ + (size_t)qb * 256) * DIN + ZC_Q + h * HD, KT + img, VT + img,
                                 MIXb + ((size_t)b * SEQ + (size_t)qb * 256) * MIXW + 2048 + h * HD, SEQ / 64, lds, qn, rope_row, rope_col, qb * 256);
        asm volatile("s_waitcnt lgkmcnt(0)" ::: "memory"); __builtin_amdgcn_s_barrier(); asm volatile("" ::: "memory"); }
}

#ifndef PH_MASK
#define PH_MASK 0xFFFF
#endif
#define PH(n) constexpr ((PH_MASK >> (n)) & 1)
#ifndef REP_MASK
#define REP_MASK 0
#endif
#define REP(n) constexpr ((REP_MASK >> (n)) & 1)

__global__ void __launch_bounds__(512, 2) fwd_kernel(Args a_unused) {
    extern __shared__ __attribute__((aligned(16))) unsigned char lds_raw[];
    LAS unsigned char* lds = (LAS unsigned char*)lds_raw;
    for (int u = threadIdx.x; u < (LDS_BYTES - LDSCTL_OFF) / 4; u += 512) ((LAS unsigned*)(lds + LDSCTL_OFF))[u] = 0u;
    __syncthreads();
    XcdBarrier bar = xcd_barrier_post((unsigned*)(((unsigned char*)kargs()->ws) + WS_CTL), (volatile LAS unsigned*)(lds + LDSCTL_OFF + 64));

    if PH(0) phase_prologue(lds);
    xcd_barrier(bar);

    for (int layer = 0; layer < DEPTH; ++layer) {
        for (int grp = 0; grp < NGRP; ++grp) {
            if PH(2) { KArgs a = kargs(); unsigned char* ws = ARG(ws); pg8::EpiBf16 E{(bf16_t*)(ws + WS_Z), DIN, (const unsigned*)(ws + WS_SS) + (size_t)grp * TG};
                pg8::gemm_phase<pg8::EpiBf16, TG, DIN, DM>(lds, (const bf16_t*)(ws + WS_XBA) + (size_t)grp * TG * DM, (const bf16_t*)(ws + WS_WIN) + (size_t)layer * DIN * DM, gridDim.x, blockIdx.x, E); }
            xcd_barrier(bar);
            if PH(3) { phase_sgu(layer, lds); phase_conv_k(layer, grp); }
            xcd_barrier(bar);
            if PH(4) phase_attention(layer, lds);
            xcd_barrier(bar);
            if PH(5) { KArgs a = kargs(); unsigned char* ws = ARG(ws); pg8::EpiMerge E{(const bf16_t*)(ws + WS_Z) + ZC_G, ARG(gate_bias) + (size_t)layer * 3 * DM, (bf16_t*)(ws + WS_MRG)};
                pg8::gemm_phase<pg8::EpiMerge, TG, DM, MIXW>(lds, (const bf16_t*)(ws + WS_MIX), (const bf16_t*)(ws + WS_WBR) + (size_t)layer * DM * MIXW, gridDim.x, blockIdx.x, E); }
            xcd_barrier(bar);
            if PH(6) { KArgs a = kargs(); unsigned char* ws = ARG(ws);
                pg8::EpiResidSS E{(const bf16_t*)(ws + WS_XBA) + (size_t)grp * TG * DM, (bf16_t*)(ws + WS_H), (unsigned*)(ws + WS_SS) + (size_t)3 * TG};
                pg8::gemm_phase<pg8::EpiResidSS, TG, DM, DM>(lds, (const bf16_t*)(ws + WS_MRG), (const bf16_t*)(ws + WS_WOUT) + (size_t)layer * DM * DM, gridDim.x, blockIdx.x, E); }
            xcd_barrier(bar);
            if PH(8) { KArgs a = kargs(); unsigned char* ws = ARG(ws); pg8::EpiSwiGLU E{(bf16_t*)(ws + WS_ACT), DFF, (const unsigned*)(ws + WS_SS) + (size_t)3 * TG};
                pg8::gemm_phase<pg8::EpiSwiGLU, TG, NFF2, DM>(lds, (const bf16_t*)(ws + WS_H), (const bf16_t*)(ws + WS_WFI) + (size_t)layer * NFF2 * DM, gridDim.x, blockIdx.x, E); }
            xcd_barrier(bar);
            if PH(9) { KArgs a = kargs(); unsigned char* ws = ARG(ws);
                pg8::EpiResidSS E{(const bf16_t*)(ws + WS_H), (bf16_t*)(ws + WS_XBA) + (size_t)grp * TG * DM, (unsigned*)(ws + WS_SS) + (size_t)grp * TG};
                pg8::gemm_phase<pg8::EpiResidSS, TG, DM, DFF>(lds, (const bf16_t*)(ws + WS_ACT), (const bf16_t*)(ws + WS_WFO) + (size_t)layer * DM * DFF, gridDim.x, blockIdx.x, E); }
            xcd_barrier(bar);
        }
    }

    if PH(10) {
        KArgs a = kargs(); const int tid = opaque_tid(), lane = tid & 63, wave = __builtin_amdgcn_readfirstlane(tid >> 6);
        const int gw = blockIdx.x * 8 + wave, NGW = gridDim.x * 8; float* out = ARG(out); const bf16_t* XBA = (const bf16_t*)(ARG(ws) + WS_XBA);
        const f32x4* gr = (const f32x4*)ARG(norm_final) + 2 * lane; f32x4 gv[8];
#pragma unroll
        for (int j = 0; j < 4; ++j) { gv[2 * j] = gr[128 * j]; gv[2 * j + 1] = gr[128 * j + 1]; }
        for (int m = gw; m < NTOK; m += NGW) {
            const u32x4* xr = (const u32x4*)(XBA + (size_t)m * DM) + lane; f32x4 v[8]; float ss = 0.f;
#pragma unroll
            for (int j = 0; j < 4; ++j) { const u32x4 b = xr[64 * j]; v[2 * j] = (f32x4){bf_lo(b.x), bf_hi(b.x), bf_lo(b.y), bf_hi(b.y)}; v[2 * j + 1] = (f32x4){bf_lo(b.z), bf_hi(b.z), bf_lo(b.w), bf_hi(b.w)}; }
#pragma unroll
            for (int j = 0; j < 8; ++j) ss += (v[j].x * v[j].x + v[j].y * v[j].y) + (v[j].z * v[j].z + v[j].w * v[j].w);
            const float rstd = 1.0f / sqrtf(wave_sum(ss) * (1.0f / DM) + EPS);
            f32x4* orow = (f32x4*)(out + (size_t)m * DM) + 2 * lane;
#pragma unroll
            for (int j = 0; j < 4; ++j) { orow[128 * j] = v[2 * j] * rstd * gv[2 * j]; orow[128 * j + 1] = v[2 * j + 1] * rstd * gv[2 * j + 1]; }
        }
    }
}

extern "C" void kernel_launch(void* const* d_in, const int* in_sizes, int n_in, void* d_out, int out_size, void* d_ws, size_t ws_size, hipStream_t stream) {
    static int grid = 0;
    if (grid == 0) {
        if (n_in != 19 || out_size != NTOK * DM || ws_size < WS_END) { fprintf(stderr, "kernel_launch: unexpected shapes: n_in %d out %d ws %zu (need %zu)\n", n_in, out_size, ws_size, (size_t)WS_END); grid = -1; return; }
        int dev = 0, cus = 0, per_cu = 0;
        if (hipGetDevice(&dev) != hipSuccess || hipDeviceGetAttribute(&cus, hipDeviceAttributeMultiprocessorCount, dev) != hipSuccess) { fprintf(stderr, "kernel_launch: device query failed\n"); grid = -1; return; }
        if (hipFuncSetAttribute((const void*)fwd_kernel, hipFuncAttributeMaxDynamicSharedMemorySize, LDS_BYTES) != hipSuccess) { fprintf(stderr, "kernel_launch: hipFuncSetAttribute failed\n"); grid = -1; return; }
        if (hipOccupancyMaxActiveBlocksPerMultiprocessor(&per_cu, (const void*)fwd_kernel, 512, LDS_BYTES) != hipSuccess || per_cu < 1) { fprintf(stderr, "kernel_launch: occupancy query says %d blocks per CU\n", per_cu); }
        (void)hipGetLastError();
        grid = cus;
    }
    if (grid < 0) return;
    if (hipMemsetAsync((char*)d_ws + WS_CTL, 0, CTL_ZERO_BYTES, stream) != hipSuccess) { fprintf(stderr, "kernel_launch: memset failed\n"); return; }
    Args a{};
    a.x_prompt = (const float*)d_in[0]; a.x_sample = (const float*)d_in[1]; a.norm_mix = (const float*)d_in[2]; a.w_in = (const float*)d_in[3]; a.gate_bias = (const float*)d_in[4];
    a.conv_w = (const float*)d_in[5]; a.sgu_ln = (const float*)d_in[6]; a.sgu_ws = (const float*)d_in[7]; a.sgu_b = (const float*)d_in[8]; a.q_norm = (const float*)d_in[9];
    a.k_norm = (const float*)d_in[10]; a.w_br_conv = (const float*)d_in[11]; a.w_br_sgu = (const float*)d_in[12]; a.w_br_attn = (const float*)d_in[13]; a.w_out = (const float*)d_in[14];
    a.norm_ffn = (const float*)d_in[15]; a.w_ffn_in = (const float*)d_in[16]; a.w_ffn_out = (const float*)d_in[17]; a.norm_final = (const float*)d_in[18];
    a.out = (float*)d_out; a.ws = (unsigned char*)d_ws;
    hipLaunchKernelGGL(fwd_kernel, dim3(grid), dim3(512), LDS_BYTES, stream, a);
    const hipError_t le = hipPeekAtLastError();
    if (le != hipSuccess) fprintf(stderr, "kernel_launch: launch failed: %s\n", hipGetErrorName(le));
}
```

```cpp
#include <hip/hip_runtime.h>
#ifndef RELAX
#define RELAX 0
#endif
#include <cstdio>
#include <cstdint>

#define LAS __attribute__((address_space(3)))
typedef unsigned short bf16_t;
typedef short bf16x8 __attribute__((ext_vector_type(8)));
typedef short s16x4 __attribute__((ext_vector_type(4)));
typedef float f32x2 __attribute__((ext_vector_type(2)));
typedef float f32x4 __attribute__((ext_vector_type(4)));
typedef float f32x16 __attribute__((ext_vector_type(16)));
typedef unsigned u32x2 __attribute__((ext_vector_type(2)));
typedef unsigned u32x4 __attribute__((ext_vector_type(4)));

constexpr int DM = 2048, DIN = 14336, DFF = 5632, NFF2 = 11264, HD = 128, NQH = 16, NKV = 4, SEQ = 8192, DEPTH = 4;
constexpr int TG = 16384, NGRP = 3, NTOK = 49152;
constexpr int ZC_CB = 0, ZC_CC = 1024, ZC_CX = 2048, ZC_SU = 3072, ZC_SV = 4096, ZC_Q = 5120, ZC_K = 7168, ZC_V = 7680, ZC_G = 8192;
constexpr int MIXW = 4096;
constexpr float EPS = 1e-6f;

constexpr size_t MiB = (size_t)1 << 20;
constexpr size_t WS_CTL = 0, CTL_ZERO_BYTES = 64 * 1024;
constexpr size_t WS_ROPE = 1 * MiB;
constexpr size_t WS_SGUW = 2 * MiB;
constexpr size_t WS_WIN = 4 * MiB;
constexpr size_t WS_WBR = WS_WIN + 224 * MiB;
constexpr size_t WS_WOUT = WS_WBR + 64 * MiB;
constexpr size_t WS_WFI = WS_WOUT + 32 * MiB;
constexpr size_t WS_WFO = WS_WFI + 176 * MiB;
constexpr size_t WS_H = WS_WFO + 88 * MiB;
constexpr size_t WS_Z = WS_H + 64 * MiB;
constexpr size_t WS_MIX = WS_Z + 448 * MiB;
constexpr size_t WS_MRG = WS_MIX + 128 * MiB;
constexpr size_t WS_ACT = WS_MRG + 64 * MiB;
constexpr size_t WS_XBA = WS_ACT + 176 * MiB;
constexpr size_t WS_SS = WS_XBA + 192 * MiB;
constexpr size_t WS_KT = WS_SS + 1 * MiB;
constexpr size_t WS_VT = WS_KT + 16 * MiB;
constexpr size_t WS_END = WS_VT + 16 * MiB;
constexpr float SS_SCALE = 1024.0f, SS_INV = 1.0f / 1024.0f;

constexpr int RING_BYTES = 131072, LDSCTL_OFF = RING_BYTES, LDS_BYTES = 147456;

#define LDS_WAIT() asm volatile("s_waitcnt lgkmcnt(0)" ::: "memory")
#define VM_WAIT() asm volatile("s_waitcnt vmcnt(0)" ::: "memory")

__device__ __forceinline__ unsigned cvt_pk_bf16(float lo, float hi) { unsigned r; asm volatile("v_cvt_pk_bf16_f32 %0, %1, %2" : "=v"(r) : "v"(lo), "v"(hi)); return r; }
__device__ __forceinline__ float bf_lo(unsigned w) { return __uint_as_float(w << 16); }
__device__ __forceinline__ float bf_hi(unsigned w) { return __uint_as_float(w & 0xffff0000u); }
template <int X> __device__ __forceinline__ float swz_xor(float v) { return __int_as_float(__builtin_amdgcn_ds_swizzle(__float_as_int(v), (X << 10) | 0x1F)); }
__device__ __forceinline__ float xor32_sum(float v) { auto r = __builtin_amdgcn_permlane32_swap(__float_as_uint(v), __float_as_uint(v), false, false); return __uint_as_float(r[0]) + __uint_as_float(r[1]); }
__device__ __forceinline__ float wave_sum(float v) {
    v += swz_xor<1>(v); v += swz_xor<2>(v); v += swz_xor<4>(v); v += swz_xor<8>(v); v += swz_xor<16>(v);
    return xor32_sum(v);
}
__device__ __forceinline__ float fast_exp(float x) { return __builtin_amdgcn_exp2f(x * 1.4426950408889634f); }
__device__ __forceinline__ float clampg(float x) { return fminf(fmaxf(x, -30.f), 30.f); }

#define XB_TMO      128
#define XB_XCNT(j)  (256  + 64 * (j))
#define XB_XSUB(j)  (1280 + 64 * (j))
#define XB_XGEN(j)  (2304 + 64 * (j))
#define XB_TOP      3328
#define XB_TOPGEN   3392
#define XCD_BAR_WORDS 3456
#define XB_LID      4608
#define XB_SPIN_CAP (1u << 18)

#define XB_G(p) ((__attribute__((address_space(1))) unsigned*)(p))
__device__ __forceinline__ unsigned xb_ld(unsigned* p)              { return __hip_atomic_load(XB_G(p), __ATOMIC_RELAXED, __HIP_MEMORY_SCOPE_AGENT); }
__device__ __forceinline__ unsigned xb_add(unsigned* p, unsigned v) { return __hip_atomic_fetch_add(XB_G(p), v, __ATOMIC_RELAXED, __HIP_MEMORY_SCOPE_AGENT); }
__device__ __forceinline__ unsigned xb_xcc_id() { return (unsigned)__builtin_amdgcn_s_getreg((3 << 11) | 20) & 0xFu; }
#define XB_SPIN(cond, bar) do { unsigned _sp = 0; while (cond) { __builtin_amdgcn_s_sleep(1); \
    if ((++_sp & 255u) == 0u) { if (xb_ld(&(bar)[XB_TMO])) break; if (_sp > XB_SPIN_CAP) { (void)xb_add(&(bar)[XB_TMO], 1u); break; } } } } while (0)

struct XcdBarrier { unsigned* bar; unsigned x; volatile LAS unsigned* st; };

__device__ __forceinline__ XcdBarrier xcd_barrier_post(unsigned* bar, volatile LAS unsigned* st) {
    XcdBarrier b; b.bar = bar; b.x = xb_xcc_id(); b.st = st;
    unsigned bid = blockIdx.x; asm volatile("" : "+s"(bid));
    if (threadIdx.x == 0) { (void)xb_add(&bar[XB_XCNT(b.x)], 1u); __hip_atomic_store(XB_G(&bar[XB_LID + bid]), b.x + 1u, __ATOMIC_RELAXED, __HIP_MEMORY_SCOPE_AGENT); }
    return b;
}
__device__ __forceinline__ void xcd_barrier_complete(unsigned* bar, unsigned x, unsigned& nloc, unsigned& nx) {
    const unsigned G = gridDim.x * gridDim.y * gridDim.z;
    unsigned sum, cnt, mine, sp = 0u;
    for (;;) {
        sum = 0u; cnt = 0u; mine = 0u;
#pragma unroll
        for (unsigned j = 0; j < 16; ++j) { const unsigned c = xb_ld(&bar[XB_XCNT(j)]); sum += c; cnt += (c > 0u) ? 1u : 0u; mine = (j == x) ? c : mine; }
        if (sum == G) break;
        __builtin_amdgcn_s_sleep(1);
        if ((++sp & 255u) == 0u) { if (xb_ld(&bar[XB_TMO])) break; if (sp > XB_SPIN_CAP) { (void)xb_add(&bar[XB_TMO], 1u); break; } }
    }
    nloc = mine > 0u ? mine : 1u; nx = cnt > 0u ? cnt : 1u;
}
__device__ __forceinline__ void xcd_barrier(const XcdBarrier& b, bool local = false) {
    asm volatile("s_waitcnt vmcnt(0)" ::: "memory");
    __syncthreads();
    if (threadIdx.x == 0) {
        unsigned* bar = b.bar; unsigned bx_ = b.x; asm volatile("" : "+s"(bar), "+s"(bx_));
        __builtin_amdgcn_s_waitcnt(0);
        unsigned nloc = b.st[0], nx = b.st[1];
        if (nloc == 0u) { xcd_barrier_complete(bar, bx_, nloc, nx); b.st[0] = nloc; b.st[1] = nx; }
        const unsigned old = xb_add(&bar[XB_XSUB(bx_)], 1u);
        const unsigned gen = old / nloc;
        if (old + 1u == (gen + 1u) * nloc) {
            if (!local) {
                __builtin_amdgcn_fence(__ATOMIC_RELEASE, "agent");
                asm volatile("s_waitcnt vmcnt(0)" ::: "memory");
                const unsigned og = xb_add(&bar[XB_TOP], 1u);
                const unsigned tg = og / nx;
                if (og + 1u == (tg + 1u) * nx) xb_add(&bar[XB_TOPGEN], 1u);
                else XB_SPIN(xb_ld(&bar[XB_TOPGEN]) == tg, bar);
            }
            __builtin_amdgcn_fence(__ATOMIC_ACQUIRE, "agent");
            xb_add(&bar[XB_XGEN(bx_)], 1u);
            asm volatile("s_waitcnt vmcnt(0)" ::: "memory");
        } else {
            XB_SPIN(xb_ld(&bar[XB_XGEN(bx_)]) == gen, bar);
            __builtin_amdgcn_fence(__ATOMIC_ACQUIRE, "agent");
            asm volatile("s_waitcnt vmcnt(0)" ::: "memory");
        }
    }
    __syncthreads();
}

__device__ __forceinline__ void cls_fast(const XcdBarrier& b, volatile LAS unsigned* flag) {
    if (threadIdx.x == 0) *flag = ((gridDim.x & 7u) == 0u && gridDim.x <= 512u) ? 1u : 0u;
    __syncthreads();
    if (threadIdx.x < gridDim.x) {
        const unsigned mine = xb_ld(&b.bar[XB_LID + threadIdx.x]), rep = xb_ld(&b.bar[XB_LID + (threadIdx.x & 7u)]);
        if (mine == 0u || mine != rep) *flag = 0u; }
    __syncthreads();
}

namespace pg8 {
constexpr int BM = 256, BK = 64, HALF = 128, HTB = HALF * BK * 2, STAGE_BYTES = 8 * HTB, NXCD = 8, WGM = 8;
__host__ __device__ __forceinline__ int lds_byte(int r, int c) { const int st = (r >> 4) * 2 + (c >> 5), rr = r & 15, cc = c & 31, ob = rr * 64 + cc * 2; return st * 1024 + (ob ^ (((ob >> 9) & 1) << 5)); }
__host__ __device__ __forceinline__ void stage_rc(int b, int& R, int& C) { const int st = b / 1024, sb = b % 1024, swz = sb ^ (((sb >> 9) & 1) << 5); R = (st >> 1) * 16 + swz / 64; C = (st & 1) * 32 + (swz % 64) / 2; }
__host__ __device__ __forceinline__ int perm32(int rho) { const int n = rho >> 4, i = rho & 15; return 8 * (i >> 2) + 4 * n + (i & 3); }

struct Unit { int pm, pn; };

template <int M, int N> struct StaticOrder {
    static constexpr int nM = M / BM, nN = N / BM, nwg = nM * nN;
    int G, c;
    __device__ __forceinline__ bool next(int i, Unit& u) const {
        const long L = (long)i * G + c; if (L >= nwg) return false;
        int wgid = (int)L; { const int q = nwg / NXCD, r = nwg % NXCD, xcd = wgid % NXCD, off = wgid / NXCD; wgid = (xcd < r ? xcd * (q + 1) : r * (q + 1) + (xcd - r) * q) + off; }
        const int nig = WGM * nN, gid = wgid / nig, fm = gid * WGM, gsz = (nM - fm) < WGM ? (nM - fm) : WGM;
        u.pm = fm + ((wgid % nig) % gsz); u.pn = (wgid % nig) / gsz; return true;
    }
};

typedef f32x4 Acc[2][2][4][2];

__device__ __forceinline__ void st_b128(void* p, u32x4 w) { asm volatile("global_store_dwordx4 %0, %1, off\n\ts_nop 1" :: "v"(p), "v"(w) : "memory"); }
__device__ __forceinline__ void st_b128_wt(void* p, u32x4 w) { asm volatile("global_store_dwordx4 %0, %1, off sc0 sc1\n\ts_nop 1" :: "v"(p), "v"(w) : "memory"); }
__device__ __forceinline__ unsigned ld_u32_asm(const unsigned* p) { unsigned v; asm volatile("global_load_dword %0, %1, off" : "=v"(v) : "v"(p) : "memory"); return v; }
__device__ __forceinline__ void atomic_add_u32_noret(unsigned* p, unsigned v) { asm volatile("global_atomic_add %0, %1, off" :: "v"(p), "v"(v) : "memory"); }
__device__ __forceinline__ float rstd_from(unsigned s) { return __builtin_amdgcn_rsqf((float)s * (SS_INV / DM) + EPS); }
typedef unsigned Pre[8];
struct EpiBf16 {
    static constexpr bool PERM = true, HOOK = false, PRE = true; static constexpr int TAIL = 24;
    __device__ __forceinline__ void prefetch(Pre& pre, const Unit& u, int wr, int fr) const {
#pragma unroll
        for (int i = 0; i < 8; ++i) pre[i] = ld_u32_asm(ss + (u.pm * BM + wr * 64 + fr + (i >> 2) * HALF + (i & 3) * 16)); }
    bf16_t* O; int ldc; const unsigned* ss;
    __device__ __forceinline__ void hook(Acc&, const Unit&, int, int, int, int, int) const {}
    __device__ __forceinline__ void operator()(Acc& acc, const Unit& u, int wr, int wc, int fr, int fq, const Pre& pre) const {
        int row0 = u.pm * BM + wr * 64 + fr; asm volatile("" : "+v"(row0)); const int col0 = u.pn * BM + wc * 32 + 8 * fq;
#pragma unroll
        for (int ai = 0; ai < 2; ++ai)
#pragma unroll
            for (int m = 0; m < 4; ++m) { const size_t r = (size_t)(row0 + ai * HALF + m * 16); bf16_t* rowp = O + r * ldc + col0; const float rs = rstd_from(pre[ai * 4 + m]);
#pragma unroll
                for (int bj = 0; bj < 2; ++bj) { const f32x4 v0 = acc[ai][bj][m][0] * rs, v1 = acc[ai][bj][m][1] * rs;
                    u32x4 w; w.x = cvt_pk_bf16(v0[0], v0[1]); w.y = cvt_pk_bf16(v0[2], v0[3]); w.z = cvt_pk_bf16(v1[0], v1[1]); w.w = cvt_pk_bf16(v1[2], v1[3]);
                    st_b128_wt(rowp + bj * HALF, w); } }
    }
};
struct EpiSwiGLU {
    static constexpr bool PERM = true, HOOK = false, PRE = true; static constexpr int TAIL = 16;
    __device__ __forceinline__ void prefetch(Pre& pre, const Unit& u, int wr, int fr) const {
#pragma unroll
        for (int i = 0; i < 8; ++i) pre[i] = ld_u32_asm(ss + (u.pm * BM + wr * 64 + fr + (i >> 2) * HALF + (i & 3) * 16)); }
    bf16_t* O; int ldc; const unsigned* ss;
    __device__ __forceinline__ void hook(Acc&, const Unit&, int, int, int, int, int) const {}
    __device__ __forceinline__ void operator()(Acc& acc, const Unit& u, int wr, int wc, int fr, int fq, const Pre& pre) const {
        int row0 = u.pm * BM + wr * 64 + fr; asm volatile("" : "+v"(row0)); const int col0 = u.pn * HALF + wc * 32 + 8 * fq;
#pragma unroll
        for (int ai = 0; ai < 2; ++ai)
#pragma unroll
            for (int m = 0; m < 4; ++m) { const size_t r = (size_t)(row0 + ai * HALF + m * 16); bf16_t* rowp = O + r * ldc + col0; const float rs = rstd_from(pre[ai * 4 + m]);
                float o[8];
#pragma unroll
                for (int n = 0; n < 2; ++n)
#pragma unroll
                    for (int e = 0; e < 4; ++e) { const float g = acc[ai][0][m][n][e] * rs, up = acc[ai][1][m][n][e] * rs;
                        o[n * 4 + e] = g * __builtin_amdgcn_rcpf(1.0f + fast_exp(-g)) * up; }
                u32x4 w; w.x = cvt_pk_bf16(o[0], o[1]); w.y = cvt_pk_bf16(o[2], o[3]); w.z = cvt_pk_bf16(o[4], o[5]); w.w = cvt_pk_bf16(o[6], o[7]);
                st_b128_wt(rowp, w); }
    }
};
struct EpiResidSS {
    static constexpr bool PERM = true, HOOK = false, PRE = false; static constexpr int TAIL = 24;
    __device__ __forceinline__ void prefetch(Pre&, const Unit&, int, int) const {}
    const bf16_t* base; bf16_t* xb; unsigned* ss;
    __device__ __forceinline__ void hook(Acc&, const Unit&, int, int, int, int, int) const {}
    __device__ __forceinline__ void operator()(Acc& acc, const Unit& u, int wr, int wc, int fr, int fq, const Pre& pre) const {
        int row0 = u.pm * BM + wr * 64 + fr; asm volatile("" : "+v"(row0)); const int col0 = u.pn * BM + wc * 32 + 8 * fq;
        u32x4 b[8][2];
#pragma unroll
        for (int i = 0; i < 8; ++i)
#pragma unroll
            for (int bj = 0; bj < 2; ++bj) b[i][bj] = *(const u32x4*)(base + (size_t)(row0 + (i >> 2) * HALF + (i & 3) * 16) * DM + col0 + bj * HALF);
        asm volatile("" : "+v"(b[0][0]), "+v"(b[0][1]), "+v"(b[1][0]), "+v"(b[1][1]), "+v"(b[2][0]), "+v"(b[2][1]), "+v"(b[3][0]), "+v"(b[3][1]));
        asm volatile("" : "+v"(b[4][0]), "+v"(b[4][1]), "+v"(b[5][0]), "+v"(b[5][1]), "+v"(b[6][0]), "+v"(b[6][1]), "+v"(b[7][0]), "+v"(b[7][1]));
#pragma unroll
        for (int i = 0; i < 8; ++i) { const size_t r = (size_t)(row0 + (i >> 2) * HALF + (i & 3) * 16), off = r * DM + col0; float sq = 0.f;
#pragma unroll
            for (int bj = 0; bj < 2; ++bj) { const u32x4 bb = b[i][bj];
                const f32x4 v0 = (f32x4){bf_lo(bb.x), bf_hi(bb.x), bf_lo(bb.y), bf_hi(bb.y)} + acc[i >> 2][bj][i & 3][0], v1 = (f32x4){bf_lo(bb.z), bf_hi(bb.z), bf_lo(bb.w), bf_hi(bb.w)} + acc[i >> 2][bj][i & 3][1];
                u32x4 w; w.x = cvt_pk_bf16(v0[0], v0[1]); w.y = cvt_pk_bf16(v0[2], v0[3]); w.z = cvt_pk_bf16(v1[0], v1[1]); w.w = cvt_pk_bf16(v1[2], v1[3]);
                st_b128(xb + off + bj * HALF, w);
                sq += (v0[0] * v0[0] + v0[1] * v0[1]) + (v0[2] * v0[2] + v0[3] * v0[3]) + (v1[0] * v1[0] + v1[1] * v1[1]) + (v1[2] * v1[2] + v1[3] * v1[3]); }
            sq += swz_xor<16>(sq); sq = xor32_sum(sq);
            if (fq == 0) atomic_add_u32_noret(ss + r, (unsigned)(sq * SS_SCALE + 0.5f)); }
    }
};
struct EpiMerge {
    static constexpr bool PERM = true, HOOK = true, PRE = false; static constexpr int TAIL = 8;
    __device__ __forceinline__ void prefetch(Pre&, const Unit&, int, int) const {}
    const bf16_t* zg; const float* gb; bf16_t* O;
    __device__ __forceinline__ void hook(Acc& acc, const Unit& u, int stage, int wr, int wc, int fr, int fq) const {
        int row0 = u.pm * BM + wr * 64 + fr; asm volatile("" : "+v"(row0)); const int col0 = u.pn * BM + wc * 32 + 8 * fq;
#pragma unroll
        for (int bj = 0; bj < 2; ++bj) {
            f32x4 ba[2], bb[2];
#pragma unroll
            for (int n = 0; n < 2; ++n) { ba[n] = *(const f32x4*)(gb + stage * DM + col0 + bj * HALF + 4 * n); bb[n] = *(const f32x4*)(gb + (stage + 1) * DM + col0 + bj * HALF + 4 * n); }
#pragma unroll
            for (int ai = 0; ai < 2; ++ai) { u32x4 ga[4], gv[4];
#pragma unroll
                for (int m = 0; m < 4; ++m) { const bf16_t* rowp = zg + (size_t)(row0 + ai * HALF + m * 16) * DIN + stage * DM + col0 + bj * HALF;
                    ga[m] = *(const u32x4*)rowp; gv[m] = *(const u32x4*)(rowp + DM); }
                asm volatile("" : "+v"(ga[0]), "+v"(ga[1]), "+v"(ga[2]), "+v"(ga[3]), "+v"(gv[0]), "+v"(gv[1]), "+v"(gv[2]), "+v"(gv[3]));
#pragma unroll
                for (int m = 0; m < 4; ++m)
#pragma unroll
                    for (int n = 0; n < 2; ++n)
#pragma unroll
                        for (int e = 0; e < 4; ++e) { const unsigned wa = ga[m][n * 2 + (e >> 1)], wb = gv[m][n * 2 + (e >> 1)];
                            const float xa = ((e & 1) ? bf_hi(wa) : bf_lo(wa)) + ba[n][e], xb = ((e & 1) ? bf_hi(wb) : bf_lo(wb)) + bb[n][e];
                            const float ea = fast_exp(-clampg(xa)), eb = fast_exp(-clampg(xb));
                            acc[ai][bj][m][n][e] *= (1.0f + eb) * __builtin_amdgcn_rcpf(1.0f + ea); }
                asm volatile("" ::: "memory"); }
        }
    }
    __device__ __forceinline__ void operator()(Acc& acc, const Unit& u, int wr, int wc, int fr, int fq, const Pre& pre) const {
        int row0 = u.pm * BM + wr * 64 + fr; asm volatile("" : "+v"(row0)); const int col0 = u.pn * BM + wc * 32 + 8 * fq;
#pragma unroll
        for (int bj = 0; bj < 2; ++bj) {
            f32x4 bc[2]; u32x4 gc[8];
#pragma unroll
            for (int n = 0; n < 2; ++n) bc[n] = *(const f32x4*)(gb + 2 * DM + col0 + bj * HALF + 4 * n);
#pragma unroll
            for (int i = 0; i < 8; ++i) gc[i] = *(const u32x4*)(zg + (size_t)(row0 + (i >> 2) * HALF + (i & 3) * 16) * DIN + 2 * DM + col0 + bj * HALF);
            asm volatile("" : "+v"(gc[0]), "+v"(gc[1]), "+v"(gc[2]), "+v"(gc[3]), "+v"(gc[4]), "+v"(gc[5]), "+v"(gc[6]), "+v"(gc[7]));
#pragma unroll
            for (int i = 0; i < 8; ++i) { float o[8];
#pragma unroll
                for (int n = 0; n < 2; ++n)
#pragma unroll
                    for (int e = 0; e < 4; ++e) { const unsigned wcw = gc[i][n * 2 + (e >> 1)]; const float xc = ((e & 1) ? bf_hi(wcw) : bf_lo(wcw)) + bc[n][e];
                        o[n * 4 + e] = acc[i >> 2][bj][i & 3][n][e] * __builtin_amdgcn_rcpf(1.0f + fast_exp(-clampg(xc))); }
                u32x4 w; w.x = cvt_pk_bf16(o[0], o[1]); w.y = cvt_pk_bf16(o[2], o[3]); w.z = cvt_pk_bf16(o[4], o[5]); w.w = cvt_pk_bf16(o[6], o[7]);
                st_b128(O + (size_t)(row0 + (i >> 2) * HALF + (i & 3) * 16) * DM + col0 + bj * HALF, w); }
            asm volatile("" ::: "memory");
        }
    }
};

template <class Epi, int M, int N, int K>
__device__ __forceinline__ void gemm_phase(LAS unsigned char* lds, const bf16_t* gA, const bf16_t* gBt, int G_, int c_, const Epi& E) {
    int tid = threadIdx.x; asm volatile("" : "+v"(tid));
    const int wid = __builtin_amdgcn_readfirstlane(tid >> 6), lane = tid & 63, wr = wid >> 2, wc = wid & 3, fr = lane & 15, fq = lane >> 4;
    constexpr int nt = K / BK;
    StaticOrder<M, N> S; S.G = G_; S.c = c_;
    unsigned voffA[2], voffB[2];
#pragma unroll
    for (int i = 0; i < 2; ++i) { int R, C; stage_rc(tid * 16 + i * 8192, R, C); const int Rb = Epi::PERM ? ((R & ~31) + perm32(R & 31)) : R;
        voffA[i] = (unsigned)(R * K + C) * 2u; voffB[i] = (unsigned)(Rb * K + C) * 2u; }
    constexpr size_t kstep = (size_t)(BK * 2);
    constexpr size_t hstep = (size_t)HALF * K * 2;
    constexpr size_t tstep = 2 * hstep;
    const unsigned ldsw = (unsigned)wid * 1024u;
    const int aoff = lds_byte(wr * 64 + fr, fq * 8), boff = lds_byte(wc * 32 + fr, fq * 8);
#define PG8_SA(b, h) (((b) * 2 + (h)) * HTB)
#define PG8_SB(b, h) ((4 + (b) * 2 + (h)) * HTB)
    const unsigned ldsb = (unsigned)(uintptr_t)lds + ldsw;
#define PG8_STAGE(bufoff, gbase, voff) do { _Pragma("unroll") for (int _i = 0; _i < 2; ++_i) { \
        asm volatile("s_mov_b32 m0, %2\n\ts_nop 0\n\tglobal_load_lds_dwordx4 %0, %1" :: "v"((voff)[_i]), "s"((const char*)(gbase)), "s"(ldsb + (unsigned)((bufoff) + _i * 8192)) : "memory"); } } while (0)
#define PG8_LDA(dst, b, h) do { _Pragma("unroll") for (int m = 0; m < 4; ++m) _Pragma("unroll") for (int k = 0; k < 2; ++k) dst[m][k] = *(const LAS bf16x8*)(lds + PG8_SA(b, h) + aoff + m * 2048 + k * 1024); } while (0)
#define PG8_LDB(dst, b, h) do { _Pragma("unroll") for (int n = 0; n < 2; ++n) _Pragma("unroll") for (int k = 0; k < 2; ++k) dst[n][k] = *(const LAS bf16x8*)(lds + PG8_SB(b, h) + boff + n * 2048 + k * 1024); } while (0)
#define PG8_MMA(ai, bj, At, Bt) do { __builtin_amdgcn_s_setprio(1); _Pragma("unroll") for (int m = 0; m < 4; ++m) _Pragma("unroll") for (int n = 0; n < 2; ++n) _Pragma("unroll") for (int k = 0; k < 2; ++k) \
        acc[ai][bj][m][n] = __builtin_amdgcn_mfma_f32_16x16x32_bf16(Bt[n][k], At[m][k], acc[ai][bj][m][n], 0, 0, 0); __builtin_amdgcn_s_setprio(0); } while (0)
#define PG8_WAIT_V(n) asm volatile("s_waitcnt vmcnt(" #n ")" ::: "memory")
#define PG8_WAIT_L(n) asm volatile("s_waitcnt lgkmcnt(" #n ")" ::: "memory")
#define PG8_WAIT_V8R_(rel, N) asm volatile("s_waitcnt vmcnt(" #N ")\n\ts_cmp_lg_u32 %0, 0\n\ts_cbranch_scc1 1f\n\ts_waitcnt vmcnt(8)\n1:" :: "s"(rel) : "memory", "scc")
#define PG8_WAIT_V8R(rel) do { static_assert(Epi::TAIL == 8 || Epi::TAIL == 16 || Epi::TAIL == 24, "TAIL"); \
        if constexpr (Epi::TAIL == 8) PG8_WAIT_V8R_(rel, 16); else if constexpr (Epi::TAIL == 16) PG8_WAIT_V8R_(rel, 24); else PG8_WAIT_V8R_(rel, 32); } while (0)
#define PG8_BAR __builtin_amdgcn_s_barrier()
#define PG8_SCHED __builtin_amdgcn_sched_barrier(0)
    Unit cur, nxt; int ui = 0;
    if (!S.next(0, cur)) return;
    Acc acc;
#pragma unroll
    for (int a = 0; a < 2; ++a)
#pragma unroll
        for (int b = 0; b < 2; ++b)
#pragma unroll
            for (int m = 0; m < 4; ++m)
#pragma unroll
                for (int n = 0; n < 2; ++n) acc[a][b][m][n] = (f32x4){0.f, 0.f, 0.f, 0.f};
    bf16x8 At[4][2], B0[2][2], B1[2][2];
    const char* cA = (const char*)gA + (size_t)cur.pm * tstep; const char* cB = (const char*)gBt + (size_t)cur.pn * tstep;
    Pre pre;
    if constexpr (Epi::PRE) E.prefetch(pre, cur, wr, fr);
    PG8_STAGE(PG8_SB(0, 0), cB, voffB); PG8_STAGE(PG8_SB(0, 1), cB + hstep, voffB); PG8_STAGE(PG8_SA(0, 0), cA, voffA); PG8_STAGE(PG8_SA(0, 1), cA + hstep, voffA);
    if (wr == 1) PG8_BAR;
    PG8_WAIT_V(2); PG8_BAR;
    PG8_STAGE(PG8_SB(1, 0), cB + kstep, voffB); PG8_STAGE(PG8_SA(1, 0), cA + kstep, voffA); PG8_STAGE(PG8_SB(1, 1), cB + hstep + kstep, voffB);
    PG8_WAIT_V(6); PG8_BAR;
    __builtin_amdgcn_s_waitcnt(0x0F70);
    for (;;) {
        const bool has_next = S.next(ui + 1, nxt);
        const char* nA = has_next ? (const char*)gA + (size_t)nxt.pm * tstep : cA; const char* nB = has_next ? (const char*)gBt + (size_t)nxt.pn * tstep : cB;
        for (int t = 0; t < nt; t += 2) {
            if constexpr (Epi::HOOK) { if (t == 16 || t == 32) { PG8_SCHED; E.hook(acc, cur, t == 16 ? 0 : 1, wr, wc, fr, fq); PG8_WAIT_V(0); PG8_SCHED; } }
            const bool last = (t == nt - 2);
            const int rel = __builtin_amdgcn_readfirstlane((t == 0 && ui > 0 && RELAX) ? 1 : 0);
            const char* a1 = cA + (size_t)(t + 1) * kstep;
            const char* a2 = last ? nA : cA + (size_t)(t + 2) * kstep; const char* b2 = last ? nB : cB + (size_t)(t + 2) * kstep;
            const char* a3 = a2 + kstep; const char* b3 = b2 + kstep;
            PG8_LDB(B0, 0, 0); PG8_LDB(B1, 0, 1); PG8_SCHED; PG8_LDA(At, 0, 0); PG8_STAGE(PG8_SA(1, 1), a1 + hstep, voffA);
            PG8_WAIT_V8R(rel); PG8_WAIT_L(0); PG8_BAR; PG8_MMA(0, 0, At, B0); PG8_MMA(0, 1, At, B1); PG8_BAR; PG8_SCHED;
            PG8_LDA(At, 0, 1); PG8_STAGE(PG8_SB(0, 0), b2, voffB); PG8_STAGE(PG8_SB(0, 1), b2 + hstep, voffB); PG8_STAGE(PG8_SA(0, 0), a2, voffA);
            PG8_WAIT_V8R(rel); PG8_WAIT_L(0); PG8_BAR; PG8_MMA(1, 0, At, B0); PG8_MMA(1, 1, At, B1); PG8_BAR; PG8_SCHED;
            PG8_LDB(B0, 1, 0); PG8_LDB(B1, 1, 1); PG8_SCHED; PG8_LDA(At, 1, 0); PG8_STAGE(PG8_SA(0, 1), a2 + hstep, voffA);
            PG8_WAIT_V(8); PG8_WAIT_L(0); PG8_BAR; PG8_MMA(0, 0, At, B0); PG8_MMA(0, 1, At, B1); PG8_BAR; PG8_SCHED;
            PG8_LDA(At, 1, 1); PG8_STAGE(PG8_SB(1, 0), b3, voffB); PG8_STAGE(PG8_SB(1, 1), b3 + hstep, voffB); PG8_STAGE(PG8_SA(1, 0), a3, voffA);
            PG8_WAIT_V(8); PG8_WAIT_L(0); PG8_BAR; PG8_MMA(1, 0, At, B0); PG8_MMA(1, 1, At, B1); PG8_BAR; PG8_SCHED;
        }
        if (wr == 0) PG8_BAR;
        E(acc, cur, wr, wc, fr, fq, pre);
        if (!has_next) break;
        if constexpr (Epi::PRE) E.prefetch(pre, nxt, wr, fr);
#pragma unroll
        for (int a = 0; a < 2; ++a)
#pragma unroll
            for (int b = 0; b < 2; ++b)
#pragma unroll
                for (int m = 0; m < 4; ++m)
#pragma unroll
                    for (int n = 0; n < 2; ++n) acc[a][b][m][n] = (f32x4){0.f, 0.f, 0.f, 0.f};
        cur = nxt; cA = nA; cB = nB; ++ui;
        if (wr == 1) PG8_BAR;
    }
    PG8_WAIT_V(0);
    PG8_BAR;
#undef PG8_SA
#undef PG8_SB
#undef PG8_STAGE
#undef PG8_LDA
#undef PG8_LDB
#undef PG8_MMA
#undef PG8_WAIT_V
#undef PG8_WAIT_L
#undef PG8_WAIT_V8R
#undef PG8_WAIT_V8R_
#undef PG8_BAR
#undef PG8_SCHED
}
}

namespace att {
constexpr int D = 128, NW = 8, QBLK = 32, KVBLK = 64;
constexpr float SCALE = 0.088388347648318440f;
constexpr float THR = 8.f;
constexpr int LDQ = DIN, LDK = DIN, LDO = MIXW;
constexpr int SHM_V = KVBLK * D * 2, SHM_K = KVBLK * D * 2, SHM_ATTN = 2 * SHM_V + 2 * SHM_K + NW * 64 * 4;
#define KSWZ(row, colB) ((row) * 256 + ((colB) ^ (((row) & 7) << 4)))
#define SBAR() __builtin_amdgcn_sched_barrier(0)
__device__ __forceinline__ int crow(int r, int hi) { return (r & 3) + 8 * (r >> 2) + 4 * hi; }

__device__ __forceinline__ void partialSM(f32x16& p0, f32x16& p1, float& m_reg, float& mn, float& alpha) {
  constexpr float C = SCALE * 1.4426950408889634f;
  float pmax = p0[0];
#pragma unroll
  for (int r = 1; r < 16; ++r) pmax = fmaxf(pmax, p0[r]);
#pragma unroll
  for (int r = 0; r < 16; ++r) pmax = fmaxf(pmax, p1[r]);
  { auto rr = __builtin_amdgcn_permlane32_swap(__float_as_uint(pmax), __float_as_uint(pmax), false, false);
    pmax = fmaxf(__uint_as_float(rr[0]), __uint_as_float(rr[1])); }
  if (__builtin_expect(__all(pmax - m_reg <= THR / SCALE), 1)) { mn = m_reg; alpha = 1.f; }
  else { mn = fmaxf(m_reg, pmax); alpha = __builtin_amdgcn_exp2f((m_reg - mn) * C); m_reg = mn; }
  float mnC = -mn * C;
#pragma unroll
  for (int r = 0; r < 16; ++r) p0[r] = fmaf(p0[r], C, mnC);
#pragma unroll
  for (int r = 0; r < 16; ++r) p1[r] = fmaf(p1[r], C, mnC);
#pragma unroll
  for (int r = 0; r < 16; ++r) p0[r] = __builtin_amdgcn_exp2f(p0[r]);
}
__device__ __forceinline__ void finishSM(f32x16& p0, f32x16& p1, float alpha, float& l_reg, bf16x8& pa0, bf16x8& pa1, bf16x8& pa2, bf16x8& pa3) {
#pragma unroll
  for (int r = 0; r < 16; ++r) p1[r] = __builtin_amdgcn_exp2f(p1[r]);
  float ps = 0;
#pragma unroll
  for (int r = 0; r < 16; ++r) ps += p0[r];
#pragma unroll
  for (int r = 0; r < 16; ++r) ps += p1[r];
  { auto rr = __builtin_amdgcn_permlane32_swap(__float_as_uint(ps), __float_as_uint(ps), false, false);
    ps = __uint_as_float(rr[0]) + __uint_as_float(rr[1]); }
  l_reg = l_reg * alpha + ps;
#define PK8(P, BASE, OUT) do { u32x4 w = {cvt_pk_bf16(P[BASE + 0], P[BASE + 1]), cvt_pk_bf16(P[BASE + 2], P[BASE + 3]), cvt_pk_bf16(P[BASE + 4], P[BASE + 5]), cvt_pk_bf16(P[BASE + 6], P[BASE + 7])}; \
    OUT = *reinterpret_cast<bf16x8*>(&w); } while (0)
  PK8(p0, 0, pa0); PK8(p0, 8, pa1); PK8(p1, 0, pa2); PK8(p1, 8, pa3);
#undef PK8
}
__device__ __forceinline__ void qkt(f32x16& p0, f32x16& p1, const char* Ks, const bf16x8* qr, int r32, int hi) {
  p0 = f32x16{}; p1 = f32x16{};
#pragma unroll
  for (int d0 = 0; d0 < 8; ++d0) { int cb = (d0 * 16 + hi * 8) * 2;
    bf16x8 b0 = *reinterpret_cast<const bf16x8*>(Ks + KSWZ(r32, cb));
    bf16x8 b1 = *reinterpret_cast<const bf16x8*>(Ks + KSWZ(32 + r32, cb));
    p0 = __builtin_amdgcn_mfma_f32_32x32x16_bf16(b0, qr[d0], p0, 0, 0, 0);
    p1 = __builtin_amdgcn_mfma_f32_32x32x16_bf16(b1, qr[d0], p1, 0, 0, 0); }
}
__device__ __forceinline__ int v_st(int k, int c) { const int kk = (k & ~0xC) | ((k & 4) << 1) | ((k & 8) >> 1); return ((kk >> 3) * 4 + (c >> 5)) * 512 + ((kk & 7) * 32 + (c & 31)) * 2; }
__device__ __forceinline__ int v_rd_base(int lane) { return ((lane & 3) << 3) | (((lane >> 2) & 3) << 6) | (((lane >> 4) & 1) << 5) | (((lane >> 5) & 1) << 8); }
constexpr int v_rd_off(int d0, int ks, int half) { return d0 * 512 + ks * 4096 + half * 2048; }
template <int OFF> __device__ __forceinline__ s16x4 tr_read(int vb) {
  s16x4 r; asm volatile("ds_read_b64_tr_b16 %0, %1 offset:%2" : "=&v"(r) : "v"(vb), "i"(OFF) : "memory"); return r;
}
template <int D0> __device__ __forceinline__ void pv_one(f32x16& od, int vb, bf16x8 pa0, bf16x8 pa1, bf16x8 pa2, bf16x8 pa3) {
  const s16x4 l0 = tr_read<v_rd_off(D0, 0, 0)>(vb), h0 = tr_read<v_rd_off(D0, 0, 1)>(vb), l1 = tr_read<v_rd_off(D0, 1, 0)>(vb), h1 = tr_read<v_rd_off(D0, 1, 1)>(vb);
  const s16x4 l2 = tr_read<v_rd_off(D0, 2, 0)>(vb), h2 = tr_read<v_rd_off(D0, 2, 1)>(vb), l3 = tr_read<v_rd_off(D0, 3, 0)>(vb), h3 = tr_read<v_rd_off(D0, 3, 1)>(vb);
  asm volatile("s_waitcnt lgkmcnt(0)" ::: "memory"); SBAR();
#define PK(L, H) (bf16x8){L[0], L[1], L[2], L[3], H[0], H[1], H[2], H[3]}
  od = __builtin_amdgcn_mfma_f32_32x32x16_bf16(pa0, PK(l0, h0), od, 0, 0, 0);
  od = __builtin_amdgcn_mfma_f32_32x32x16_bf16(pa1, PK(l1, h1), od, 0, 0, 0);
  od = __builtin_amdgcn_mfma_f32_32x32x16_bf16(pa2, PK(l2, h2), od, 0, 0, 0);
  od = __builtin_amdgcn_mfma_f32_32x32x16_bf16(pa3, PK(l3, h3), od, 0, 0, 0);
#undef PK
}
__device__ __forceinline__ void pv_d0(f32x16* o, int vb, bf16x8 pa0, bf16x8 pa1, bf16x8 pa2, bf16x8 pa3) {
  pv_one<0>(o[0], vb, pa0, pa1, pa2, pa3); pv_one<1>(o[1], vb, pa0, pa1, pa2, pa3); pv_one<2>(o[2], vb, pa0, pa1, pa2, pa3); pv_one<3>(o[3], vb, pa0, pa1, pa2, pa3);
}

constexpr int RSLOT = 16384, LDS_KR = 0, LDS_VR = 3 * RSLOT, LDS_WS2 = 6 * RSLOT;
__device__ __forceinline__ void qkt_l(f32x16& p0, f32x16& p1, const LAS unsigned char* Ks, const bf16x8* qr, int r32, int hi) {
  p0 = f32x16{}; p1 = f32x16{};
#pragma unroll
  for (int d0 = 0; d0 < 8; ++d0) { int cb = (d0 * 16 + hi * 8) * 2;
    bf16x8 b0 = *reinterpret_cast<const LAS bf16x8*>(Ks + KSWZ(r32, cb));
    bf16x8 b1 = *reinterpret_cast<const LAS bf16x8*>(Ks + KSWZ(32 + r32, cb));
    p0 = __builtin_amdgcn_mfma_f32_32x32x16_bf16(b0, qr[d0], p0, 0, 0, 0);
    p1 = __builtin_amdgcn_mfma_f32_32x32x16_bf16(b1, qr[d0], p1, 0, 0, 0); }
}
__device__ __forceinline__ void attn_dense_body_dma(const bf16_t* __restrict__ Qb, const char* __restrict__ Kt, const char* __restrict__ Vt, bf16_t* __restrict__ Ob, int NT, LAS unsigned char* lds,
                                                    const float* __restrict__ qn, const f32x2* __restrict__ rope_row, const f32x2* __restrict__ rope_col, int pos0) {
  int tid = threadIdx.x; asm volatile("" : "+v"(tid));
  const int wid = __builtin_amdgcn_readfirstlane(tid >> 6), lane = tid & 63, r32 = lane & 31, hi = lane >> 5;
  LAS float* ws = (LAS float*)(lds + LDS_WS2) + wid * 64; LAS float* li_l = ws; LAS float* al_l = ws + 32;
  const unsigned dma_l = (unsigned)wid * 1024u;
  const unsigned dma_v = dma_l + (unsigned)lane * 16u;
  const unsigned ldsb = (unsigned)(uintptr_t)lds + dma_l;
#define DMA_PIECE(goff, gbase, ldst) do { asm volatile("s_mov_b32 m0, %2\n\ts_nop 0\n\tglobal_load_lds_dwordx4 %0, %1" :: "v"(goff), "s"(gbase), "s"(ldst) : "memory"); } while (0)
#define DMA_TILE(t, s) do { _Pragma("unroll") for (int _i = 0; _i < 2; ++_i) { \
    DMA_PIECE(dma_v + _i * 8192, Kt + (size_t)(t) * RSLOT, ldsb + (unsigned)(LDS_KR + (s) * RSLOT + _i * 8192)); \
    DMA_PIECE(dma_v + _i * 8192, Vt + (size_t)(t) * RSLOT, ldsb + (unsigned)(LDS_VR + (s) * RSLOT + _i * 8192)); } } while (0)
#define TILE_BAR() do { asm volatile("s_waitcnt vmcnt(0)" ::: "memory"); __builtin_amdgcn_s_barrier(); asm volatile("" ::: "memory"); } while (0)
  DMA_TILE(0, 0);
  float m_reg = -1e30f, l_reg = 0; f32x16 o[4] = {}; bf16x8 qr[8];
  const bf16_t* Qw = Qb + (long)(wid * QBLK + r32) * LDQ + hi * 8;
  {
    u32x4 raw[8];
#pragma unroll
    for (int d0 = 0; d0 < 8; ++d0) raw[d0] = *reinterpret_cast<const u32x4*>(Qw + d0 * 16);
    float y[8][8]; float ss = 0.f;
#pragma unroll
    for (int d0 = 0; d0 < 8; ++d0)
#pragma unroll
      for (int j = 0; j < 4; ++j) { y[d0][2 * j] = bf_lo(raw[d0][j]); y[d0][2 * j + 1] = bf_hi(raw[d0][j]); ss += y[d0][2 * j] * y[d0][2 * j] + y[d0][2 * j + 1] * y[d0][2 * j + 1]; }
    ss = xor32_sum(ss);
    const float rstd = 1.0f / sqrtf(ss * (1.0f / 128.0f) + EPS);
#pragma unroll
    for (int d0 = 0; d0 < 8; ++d0) { const f32x4 g0 = *(const f32x4*)(qn + d0 * 16 + hi * 8), g1 = *(const f32x4*)(qn + d0 * 16 + hi * 8 + 4);
#pragma unroll
      for (int j = 0; j < 4; ++j) { y[d0][j] *= rstd * g0[j]; y[d0][4 + j] *= rstd * g1[j]; } }
    const int pos = pos0 + wid * QBLK + r32;
#pragma unroll
    for (int blk = 0; blk < 2; ++blk) { const f32x2* tab = blk ? (rope_col + (pos & 63) * 32) : (rope_row + (pos >> 6) * 32);
#pragma unroll
      for (int dd = 0; dd < 2; ++dd) { const f32x4* tp = (const f32x4*)(tab + dd * 16 + hi * 8); const int da = 4 * blk + dd, db = da + 2;
#pragma unroll
        for (int j2 = 0; j2 < 4; ++j2) { const f32x4 cs = tp[j2];
          { const float x1 = y[da][2 * j2], x2 = y[db][2 * j2]; y[da][2 * j2] = x1 * cs[0] - x2 * cs[1]; y[db][2 * j2] = x2 * cs[0] + x1 * cs[1]; }
          { const float x1 = y[da][2 * j2 + 1], x2 = y[db][2 * j2 + 1]; y[da][2 * j2 + 1] = x1 * cs[2] - x2 * cs[3]; y[db][2 * j2 + 1] = x2 * cs[2] + x1 * cs[3]; } } } }
#pragma unroll
    for (int d0 = 0; d0 < 8; ++d0) { u32x4 w = {cvt_pk_bf16(y[d0][0], y[d0][1]), cvt_pk_bf16(y[d0][2], y[d0][3]), cvt_pk_bf16(y[d0][4], y[d0][5]), cvt_pk_bf16(y[d0][6], y[d0][7])};
      qr[d0] = *reinterpret_cast<bf16x8*>(&w); }
  }
  const int vrb = (int)(uintptr_t)(lds + LDS_VR) + v_rd_base(lane);
#define RESC(a) do { if (__any((a) < 1.f)) { if (hi == 0) al_l[r32] = (a); asm volatile("s_waitcnt lgkmcnt(0)" ::: "memory"); \
    _Pragma("unroll") for (int d = 0; d < 4; ++d) _Pragma("unroll") for (int r = 0; r < 16; ++r) o[d][r] *= al_l[crow(r, hi)]; } } while (0)
#define NEXT_SLOT(s) ((s) == 2 ? 0 : (s) + 1)
  f32x16 pA0, pA1, pB0, pB1; float mnA, mnB, alA, alB; bf16x8 pa0, pa1, pa2, pa3;
  TILE_BAR();
  DMA_TILE(1, 1);
  qkt_l(pA0, pA1, lds + LDS_KR, qr, r32, hi); partialSM(pA0, pA1, m_reg, mnA, alA);
  int sk = 1, sv = 0;
  for (int j = 1; j + 1 < NT; j += 2) {
    TILE_BAR(); { const int sn = NEXT_SLOT(sk); DMA_TILE(j + 1, sn); }
    SBAR(); qkt_l(pB0, pB1, lds + LDS_KR + sk * RSLOT, qr, r32, hi);
    finishSM(pA0, pA1, alA, l_reg, pa0, pa1, pa2, pa3); SBAR();
    pv_d0(o, vrb + sv * RSLOT, pa0, pa1, pa2, pa3); partialSM(pB0, pB1, m_reg, mnB, alB);
    RESC(alB);
    sv = sk; sk = NEXT_SLOT(sk);
    TILE_BAR(); if (j + 2 < NT) { const int sn = NEXT_SLOT(sk); DMA_TILE(j + 2, sn); }
    SBAR(); qkt_l(pA0, pA1, lds + LDS_KR + sk * RSLOT, qr, r32, hi);
    finishSM(pB0, pB1, alB, l_reg, pa0, pa1, pa2, pa3); SBAR();
    pv_d0(o, vrb + sv * RSLOT, pa0, pa1, pa2, pa3); partialSM(pA0, pA1, m_reg, mnA, alA);
    RESC(alA);
    sv = sk; sk = NEXT_SLOT(sk);
  }
  TILE_BAR();
  SBAR(); qkt_l(pB0, pB1, lds + LDS_KR + sk * RSLOT, qr, r32, hi);
  finishSM(pA0, pA1, alA, l_reg, pa0, pa1, pa2, pa3); SBAR();
  pv_d0(o, vrb + sv * RSLOT, pa0, pa1, pa2, pa3); partialSM(pB0, pB1, m_reg, mnB, alB);
  RESC(alB);
  finishSM(pB0, pB1, alB, l_reg, pa0, pa1, pa2, pa3); SBAR();
  pv_d0(o, vrb + sk * RSLOT, pa0, pa1, pa2, pa3);
  if (hi == 0) li_l[r32] = l_reg; asm volatile("s_waitcnt lgkmcnt(0)" ::: "memory");
  float rli[16];
#pragma unroll
  for (int r = 0; r < 16; ++r) rli[r] = __builtin_amdgcn_rcpf(li_l[crow(r, hi)]);
  bf16_t* Ow = Ob + (long)(wid * QBLK) * LDO;
#pragma unroll
  for (int r = 0; r < 16; ++r) { int orow = crow(r, hi);
#pragma unroll
    for (int d0 = 0; d0 < 4; ++d0) Ow[(long)orow * LDO + d0 * 32 + r32] = (bf16_t)(cvt_pk_bf16(o[d0][r] * rli[r], 0.f) & 0xffffu); }
#undef DMA_TILE
#undef DMA_PIECE
#undef TILE_BAR
#undef RESC
#undef NEXT_SLOT
}

__device__ __forceinline__ int krow(int kappa) { const int r = (kappa & 7) | ((kappa & 16) >> 1), hi = (kappa >> 3) & 1; return (r & 3) + 8 * (r >> 2) + 4 * hi; }
__device__ __forceinline__ void expA(f32x16& p0) {
#pragma unroll
  for (int r = 0; r < 16; ++r) p0[r] = __builtin_amdgcn_exp2f(p0[r]);
}
__device__ __forceinline__ void expB_pack(f32x16& p0, f32x16& p1, float& l_reg, bf16x8& pa0, bf16x8& pa1, bf16x8& pa2, bf16x8& pa3) {
#pragma unroll
  for (int r = 0; r < 16; ++r) p1[r] = __builtin_amdgcn_exp2f(p1[r]);
  float ps = 0;
#pragma unroll
  for (int r = 0; r < 16; ++r) ps += p0[r];
#pragma unroll
  for (int r = 0; r < 16; ++r) ps += p1[r];
  l_reg += ps;
#define PK8(P, BASE, OUT) do { u32x4 w = {cvt_pk_bf16(P[BASE + 0], P[BASE + 1]), cvt_pk_bf16(P[BASE + 2], P[BASE + 3]), cvt_pk_bf16(P[BASE + 4], P[BASE + 5]), cvt_pk_bf16(P[BASE + 6], P[BASE + 7])}; \
    OUT = *reinterpret_cast<bf16x8*>(&w); } while (0)
  PK8(p0, 0, pa0); PK8(p0, 8, pa1); PK8(p1, 0, pa2); PK8(p1, 8, pa3);
#undef PK8
}
__device__ __forceinline__ void attn_body_maxfree(const bf16_t* __restrict__ Qb, const char* __restrict__ Kt, const char* __restrict__ Vt, bf16_t* __restrict__ Ob, int NT, LAS unsigned char* lds,
                                                  const float* __restrict__ qn, const f32x2* __restrict__ rope_row, const f32x2* __restrict__ rope_col, int pos0) {
  int tid = threadIdx.x; asm volatile("" : "+v"(tid));
  const int wid = __builtin_amdgcn_readfirstlane(tid >> 6), lane = tid & 63, r32 = lane & 31, hi = lane >> 5;
  LAS float* li_l = (LAS float*)(lds + LDS_WS2) + wid * 64;
  const unsigned dma_l = (unsigned)wid * 1024u;
  const unsigned dma_v = dma_l + (unsigned)lane * 16u;
  const unsigned ldsb = (unsigned)(uintptr_t)lds + dma_l;
#define DMA_PIECE(goff, gbase, ldst) do { asm volatile("s_mov_b32 m0, %2\n\ts_nop 0\n\tglobal_load_lds_dwordx4 %0, %1" :: "v"(goff), "s"(gbase), "s"(ldst) : "memory"); } while (0)
#define DMA_TILE(t, s) do { _Pragma("unroll") for (int _i = 0; _i < 2; ++_i) { \
    DMA_PIECE(dma_v + _i * 8192, Kt + (size_t)(t) * RSLOT, ldsb + (unsigned)(LDS_KR + (s) * RSLOT + _i * 8192)); \
    DMA_PIECE(dma_v + _i * 8192, Vt + (size_t)(t) * RSLOT, ldsb + (unsigned)(LDS_VR + (s) * RSLOT + _i * 8192)); } } while (0)
#define TILE_BAR() do { asm volatile("s_waitcnt vmcnt(0)" ::: "memory"); __builtin_amdgcn_s_barrier(); asm volatile("" ::: "memory"); } while (0)
  DMA_TILE(0, 0);
  float l_reg = 0; f32x16 o[4] = {}; bf16x8 qr[8];
  const bf16_t* Qw = Qb + (long)(wid * QBLK + r32) * LDQ + hi * 8;
  {
    u32x4 raw[8];
#pragma unroll
    for (int d0 = 0; d0 < 8; ++d0) raw[d0] = *reinterpret_cast<const u32x4*>(Qw + d0 * 16);
    float y[8][8]; float ss = 0.f;
#pragma unroll
    for (int d0 = 0; d0 < 8; ++d0)
#pragma unroll
      for (int j = 0; j < 4; ++j) { y[d0][2 * j] = bf_lo(raw[d0][j]); y[d0][2 * j + 1] = bf_hi(raw[d0][j]); ss += y[d0][2 * j] * y[d0][2 * j] + y[d0][2 * j + 1] * y[d0][2 * j + 1]; }
    ss = xor32_sum(ss);
    const float rstd = (SCALE * 1.4426950408889634f) / sqrtf(ss * (1.0f / 128.0f) + EPS);
#pragma unroll
    for (int d0 = 0; d0 < 8; ++d0) { const f32x4 g0 = *(const f32x4*)(qn + d0 * 16 + hi * 8), g1 = *(const f32x4*)(qn + d0 * 16 + hi * 8 + 4);
#pragma unroll
      for (int j = 0; j < 4; ++j) { y[d0][j] *= rstd * g0[j]; y[d0][4 + j] *= rstd * g1[j]; } }
    const int pos = pos0 + wid * QBLK + r32;
#pragma unroll
    for (int blk = 0; blk < 2; ++blk) { const f32x2* tab = blk ? (rope_col + (pos & 63) * 32) : (rope_row + (pos >> 6) * 32);
#pragma unroll
      for (int dd = 0; dd < 2; ++dd) { const f32x4* tp = (const f32x4*)(tab + dd * 16 + hi * 8); const int da = 4 * blk + dd, db = da + 2;
#pragma unroll
        for (int j2 = 0; j2 < 4; ++j2) { const f32x4 cs = tp[j2];
          { const float x1 = y[da][2 * j2], x2 = y[db][2 * j2]; y[da][2 * j2] = x1 * cs[0] - x2 * cs[1]; y[db][2 * j2] = x2 * cs[0] + x1 * cs[1]; }
          { const float x1 = y[da][2 * j2 + 1], x2 = y[db][2 * j2 + 1]; y[da][2 * j2 + 1] = x1 * cs[2] - x2 * cs[3]; y[db][2 * j2 + 1] = x2 * cs[2] + x1 * cs[3]; } } } }
#pragma unroll
    for (int d0 = 0; d0 < 8; ++d0) { u32x4 w = {cvt_pk_bf16(y[d0][0], y[d0][1]), cvt_pk_bf16(y[d0][2], y[d0][3]), cvt_pk_bf16(y[d0][4], y[d0][5]), cvt_pk_bf16(y[d0][6], y[d0][7])};
      qr[d0] = *reinterpret_cast<bf16x8*>(&w); }
  }
  const int vrb = (int)(uintptr_t)(lds + LDS_VR) + v_rd_base(lane);
#define NEXT_SLOT(s) ((s) == 2 ? 0 : (s) + 1)
  f32x16 pA0, pA1, pB0, pB1; bf16x8 pa0, pa1, pa2, pa3;
  if (wid >= 4) __builtin_amdgcn_s_setprio(1);
  TILE_BAR();
  DMA_TILE(1, 1);
  qkt_l(pA0, pA1, lds + LDS_KR, qr, r32, hi); expA(pA0);
  int sk = 1, sv = 0;
  for (int j = 1; j + 1 < NT; j += 2) {
    TILE_BAR(); { const int sn = NEXT_SLOT(sk); DMA_TILE(j + 1, sn); }
    SBAR(); qkt_l(pB0, pB1, lds + LDS_KR + sk * RSLOT, qr, r32, hi);
    expB_pack(pA0, pA1, l_reg, pa0, pa1, pa2, pa3); SBAR();
    pv_d0(o, vrb + sv * RSLOT, pa0, pa1, pa2, pa3); expA(pB0);
    sv = sk; sk = NEXT_SLOT(sk);
    TILE_BAR(); if (j + 2 < NT) { const int sn = NEXT_SLOT(sk); DMA_TILE(j + 2, sn); }
    SBAR(); qkt_l(pA0, pA1, lds + LDS_KR + sk * RSLOT, qr, r32, hi);
    expB_pack(pB0, pB1, l_reg, pa0, pa1, pa2, pa3); SBAR();
    pv_d0(o, vrb + sv * RSLOT, pa0, pa1, pa2, pa3); expA(pA0);
    sv = sk; sk = NEXT_SLOT(sk);
  }
  TILE_BAR();
  SBAR(); qkt_l(pB0, pB1, lds + LDS_KR + sk * RSLOT, qr, r32, hi);
  expB_pack(pA0, pA1, l_reg, pa0, pa1, pa2, pa3); SBAR();
  pv_d0(o, vrb + sv * RSLOT, pa0, pa1, pa2, pa3); expA(pB0);
  expB_pack(pB0, pB1, l_reg, pa0, pa1, pa2, pa3); SBAR();
  pv_d0(o, vrb + sk * RSLOT, pa0, pa1, pa2, pa3);
  __builtin_amdgcn_s_setprio(0);
  l_reg = xor32_sum(l_reg);
  if (hi == 0) li_l[r32] = l_reg; asm volatile("s_waitcnt lgkmcnt(0)" ::: "memory");
  float rli[16];
#pragma unroll
  for (int r = 0; r < 16; ++r) rli[r] = __builtin_amdgcn_rcpf(li_l[crow(r, hi)]);
  bf16_t* Ow = Ob + (long)(wid * QBLK) * LDO;
#pragma unroll
  for (int r = 0; r < 16; ++r) { int orow = crow(r, hi);
#pragma unroll
    for (int d0 = 0; d0 < 4; ++d0) Ow[(long)orow * LDO + d0 * 32 + r32] = (bf16_t)(cvt_pk_bf16(o[d0][r] * rli[r], 0.f) & 0xffffu); }
#undef DMA_TILE
#undef DMA_PIECE
#undef TILE_BAR
#undef NEXT_SLOT
}
}

struct Args {
    const float* x_prompt; const float* x_sample; const float* norm_mix; const float* w_in; const float* gate_bias; const float* conv_w; const float* sgu_ln; const float* sgu_ws;
    const float* sgu_b; const float* q_norm; const float* k_norm; const float* w_br_conv; const float* w_br_sgu; const float* w_br_attn; const float* w_out; const float* norm_ffn;
    const float* w_ffn_in; const float* w_ffn_out; const float* norm_final; float* out; unsigned char* ws;
};
#define GASQ __attribute__((address_space(1)))
struct ArgsD {
    const GASQ float* x_prompt; const GASQ float* x_sample; const GASQ float* norm_mix; const GASQ float* w_in; const GASQ float* gate_bias; const GASQ float* conv_w; const GASQ float* sgu_ln; const GASQ float* sgu_ws;
    const GASQ float* sgu_b; const GASQ float* q_norm; const GASQ float* k_norm; const GASQ float* w_br_conv; const GASQ float* w_br_sgu; const GASQ float* w_br_attn; const GASQ float* w_out; const GASQ float* norm_ffn;
    const GASQ float* w_ffn_in; const GASQ float* w_ffn_out; const GASQ float* norm_final; GASQ float* out; GASQ unsigned char* ws;
};
static_assert(sizeof(ArgsD) == sizeof(Args), "ArgsD mirrors Args");
#define ARG(f) ((decltype(Args::f))(a->f))
typedef const __attribute__((address_space(4))) ArgsD* KArgs;
__device__ __forceinline__ KArgs kargs() { KArgs p = (KArgs)__builtin_amdgcn_kernarg_segment_ptr(); asm volatile("" : "+s"(p)); return p; }
__device__ __forceinline__ int opaque_tid() { int t = threadIdx.x; asm volatile("" : "+v"(t)); return t; }

__device__ __forceinline__ void transpose_item(const float* W, int ldw, int scol0, int k0, bf16_t* dst, int ldk, LAS float* scr, int lane, const float* gain) {
#pragma unroll 8
    for (int i = 0; i < 32; ++i) { const int kk = 2 * i + (lane >> 5); const float gk = gain ? gain[k0 + kk] : 1.0f; scr[kk * 33 + (lane & 31)] = W[(size_t)(k0 + kk) * ldw + scol0 + (lane & 31)] * gk; }
    LDS_WAIT(); asm volatile("" ::: "memory");
    const int c = lane & 7;
#pragma unroll
    for (int j = 0; j < 4; ++j) { const int n = (lane >> 3) + 8 * j; const LAS float* s = scr + (8 * c) * 33 + n;
        u32x4 o; o.x = cvt_pk_bf16(s[0 * 33], s[1 * 33]); o.y = cvt_pk_bf16(s[2 * 33], s[3 * 33]); o.z = cvt_pk_bf16(s[4 * 33], s[5 * 33]); o.w = cvt_pk_bf16(s[6 * 33], s[7 * 33]);
        *(u32x4*)(dst + (size_t)n * ldk + 8 * c) = o; }
    LDS_WAIT(); asm volatile("" ::: "memory");
}

__device__ __forceinline__ void sincos_d(double a, double& s, double& c) {
    const double k = __builtin_rint(a * 0.63661977236758134308);
    double r = a - k * 1.57079632673412561417e+00; r = r - k * 6.07710050650619224932e-11;
    const double r2 = r * r;
    double sp = -1.0 / 1307674368000.0; sp = sp * r2 + 1.0 / 6227020800.0; sp = sp * r2 - 1.0 / 39916800.0; sp = sp * r2 + 1.0 / 362880.0; sp = sp * r2 - 1.0 / 5040.0; sp = sp * r2 + 1.0 / 120.0; sp = sp * r2 - 1.0 / 6.0; sp = sp * r2 + 1.0;
    const double sn = r * sp;
    double cp = 1.0 / 20922789888000.0; cp = cp * r2 - 1.0 / 87178291200.0; cp = cp * r2 + 1.0 / 479001600.0; cp = cp * r2 - 1.0 / 3628800.0; cp = cp * r2 + 1.0 / 40320.0; cp = cp * r2 - 1.0 / 720.0; cp = cp * r2 + 1.0 / 24.0; cp = cp * r2 - 0.5; cp = cp * r2 + 1.0;
    const int q = ((int)k) & 3;
    s = (q == 0) ? sn : (q == 1) ? cp : (q == 2) ? -sn : -cp;
    c = (q == 0) ? cp : (q == 1) ? -sn : (q == 2) ? -cp : sn;
}

__device__ __forceinline__ void phase_prologue(LAS unsigned char* lds) {
    KArgs a = kargs(); const int tid = opaque_tid(), lane = tid & 63, wave = __builtin_amdgcn_readfirstlane(tid >> 6);
    const int G = gridDim.x, bx = blockIdx.x, gw = bx * 8 + wave, NGW = G * 8;
    unsigned char* ws = ARG(ws);
    bf16_t* Win_t = (bf16_t*)(ws + WS_WIN); bf16_t* Wbr_t = (bf16_t*)(ws + WS_WBR); bf16_t* Wout_t = (bf16_t*)(ws + WS_WOUT); bf16_t* Wfi_t = (bf16_t*)(ws + WS_WFI); bf16_t* Wfo_t = (bf16_t*)(ws + WS_WFO);
    LAS float* scr = (LAS float*)(lds + wave * 9216);
    constexpr int I_IN = 32 * 448, I_BC = 16 * 64, I_BA = 32 * 64, I_O = 32 * 64, I_FI = 32 * 352, I_FO = 88 * 64;
    constexpr int PER_LAYER = I_IN + 2 * I_BC + I_BA + I_O + I_FI + I_FO, TOTAL = DEPTH * PER_LAYER;
    struct TItem { const float* src; bf16_t* dst; const float* gain; int ldw, ldk; };
    auto titem = [&](int it) -> TItem {
        const int layer = it / PER_LAYER; int r = it - layer * PER_LAYER; TItem t;
        if (r < I_IN) { const int kb = r / 448, nb = r % 448, k0 = 64 * kb, n0 = 32 * nb;
            t.src = ARG(w_in) + (size_t)layer * DM * DIN + (size_t)k0 * DIN + n0; t.ldw = DIN; t.dst = Win_t + (size_t)layer * DIN * DM + (size_t)n0 * DM + k0; t.ldk = DM; t.gain = ARG(norm_mix) + layer * DM + k0; return t; }
        r -= I_IN;
        if (r < I_BC) { const int kb = r / 64, nb = r % 64, k0 = 64 * kb, n0 = 32 * nb;
            t.src = ARG(w_br_conv) + (size_t)layer * 1024 * DM + (size_t)k0 * DM + n0; t.ldw = DM; t.dst = Wbr_t + (size_t)layer * DM * MIXW + (size_t)n0 * MIXW + k0; t.ldk = MIXW; t.gain = nullptr; return t; }
        r -= I_BC;
        if (r < I_BC) { const int kb = r / 64, nb = r % 64, k0 = 64 * kb, n0 = 32 * nb;
            t.src = ARG(w_br_sgu) + (size_t)layer * 1024 * DM + (size_t)k0 * DM + n0; t.ldw = DM; t.dst = Wbr_t + (size_t)layer * DM * MIXW + (size_t)n0 * MIXW + 1024 + k0; t.ldk = MIXW; t.gain = nullptr; return t; }
        r -= I_BC;
        if (r < I_BA) { const int kb = r / 64, nb = r % 64, k0 = 64 * kb, n0 = 32 * nb;
            t.src = ARG(w_br_attn) + (size_t)layer * DM * DM + (size_t)k0 * DM + n0; t.ldw = DM; t.dst = Wbr_t + (size_t)layer * DM * MIXW + (size_t)n0 * MIXW + 2048 + k0; t.ldk = MIXW; t.gain = nullptr; return t; }
        r -= I_BA;
        if (r < I_O) { const int kb = r / 64, nb = r % 64, k0 = 64 * kb, n0 = 32 * nb;
            t.src = ARG(w_out) + (size_t)layer * DM * DM + (size_t)k0 * DM + n0; t.ldw = DM; t.dst = Wout_t + (size_t)layer * DM * DM + (size_t)n0 * DM + k0; t.ldk = DM; t.gain = nullptr; return t; }
        r -= I_O;
        if (r < I_FI) { const int kb = r / 352, nb = r % 352, k0 = 64 * kb, n0 = 32 * nb, tile = n0 >> 8, w = n0 & 255;
            const int scol0 = (w < 128) ? (128 * tile + w) : (DFF + 128 * tile + (w - 128));
            t.src = ARG(w_ffn_in) + (size_t)layer * DM * NFF2 + (size_t)k0 * NFF2 + scol0; t.ldw = NFF2; t.dst = Wfi_t + (size_t)layer * NFF2 * DM + (size_t)n0 * DM + k0; t.ldk = DM; t.gain = ARG(norm_ffn) + layer * DM + k0; return t; }
        r -= I_FI;
        { const int kb = r / 64, nb = r % 64, k0 = 64 * kb, n0 = 32 * nb;
            t.src = ARG(w_ffn_out) + (size_t)layer * DFF * DM + (size_t)k0 * DM + n0; t.ldw = DM; t.dst = Wfo_t + (size_t)layer * DM * DFF + (size_t)n0 * DFF + k0; t.ldk = DFF; t.gain = nullptr; return t; }
    };
    const float* ones_or_any = ARG(norm_final);
    const int lr = lane >> 3, lc = (lane & 7) * 4;
    if (gw < TOTAL) {
        TItem cur = titem(gw); f32x4 v[8]; float gv[8];
#pragma unroll
        for (int i = 0; i < 8; ++i) { v[i] = *(const f32x4*)(cur.src + (size_t)(8 * i + lr) * cur.ldw + lc); gv[i] = (cur.gain ? cur.gain : ones_or_any)[8 * i + lr]; }
        for (int it = gw; it < TOTAL; it += NGW) {
            const int nit = (it + NGW < TOTAL) ? it + NGW : it;
            const TItem nx = titem(nit); f32x4 nv[8]; float ng[8];
#pragma unroll
            for (int i = 0; i < 8; ++i) { nv[i] = *(const f32x4*)(nx.src + (size_t)(8 * i + lr) * nx.ldw + lc); ng[i] = (nx.gain ? nx.gain : ones_or_any)[8 * i + lr]; }
            const bool hg = cur.gain != nullptr;
#pragma unroll
            for (int i = 0; i < 8; ++i) { const float g = hg ? gv[i] : 1.0f; *(LAS f32x4*)(scr + (8 * i + lr) * 36 + lc) = v[i] * g; }
            LDS_WAIT(); asm volatile("" ::: "memory");
            { const int n = lane & 31, g2 = lane >> 5;
#pragma unroll
              for (int j = 0; j < 4; ++j) { const int c = g2 + 2 * j; const LAS float* sp = scr + (8 * c) * 36 + n;
                  u32x4 o; o.x = cvt_pk_bf16(sp[0 * 36], sp[1 * 36]); o.y = cvt_pk_bf16(sp[2 * 36], sp[3 * 36]); o.z = cvt_pk_bf16(sp[4 * 36], sp[5 * 36]); o.w = cvt_pk_bf16(sp[6 * 36], sp[7 * 36]);
                  *(u32x4*)(cur.dst + (size_t)n * cur.ldk + 8 * c) = o; } }
            LDS_WAIT(); asm volatile("" ::: "memory");
            cur = nx;
#pragma unroll
            for (int i = 0; i < 8; ++i) { v[i] = nv[i]; gv[i] = ng[i]; }
        }
    }
    const int gt = bx * 512 + tid, NT = G * 512;
    unsigned* SGUWb = (unsigned*)(ws + WS_SGUW); const f32x2* sw = (const f32x2*)ARG(sgu_ws);
    for (int i = gt; i < DEPTH * 8 * 128 * 128 / 2; i += NT) { const f32x2 v = sw[i]; SGUWb[i] = cvt_pk_bf16(v.x, v.y); }
    { bf16_t* XBA = (bf16_t*)(ws + WS_XBA); unsigned* SS = (unsigned*)(ws + WS_SS);
      for (int m = gw; m < NTOK; m += NGW) { const float* xrow = (m < 2 * TG) ? ARG(x_prompt) + (size_t)m * DM : ARG(x_sample) + (size_t)(m - 2 * TG) * DM;
          const f32x4* xr = (const f32x4*)xrow + lane; f32x4 v[8]; float sq = 0.f;
#pragma unroll
          for (int j = 0; j < 8; ++j) { v[j] = xr[64 * j]; sq += (v[j].x * v[j].x + v[j].y * v[j].y) + (v[j].z * v[j].z + v[j].w * v[j].w); }
          sq = wave_sum(sq);
          u32x2* o8 = (u32x2*)(XBA + (size_t)m * DM) + lane;
#pragma unroll
          for (int j = 0; j < 8; ++j) { u32x2 w; w.x = cvt_pk_bf16(v[j].x, v[j].y); w.y = cvt_pk_bf16(v[j].z, v[j].w); o8[64 * j] = w; }
          if (lane == 0) SS[m] = (unsigned)(sq * SS_SCALE + 0.5f); } }
    f32x2* rope = (f32x2*)(ws + WS_ROPE);
    for (int i = gt; i < 192 * 32; i += NT) { const int pos = i >> 5, f = i & 31;
        double inv = 1.0; for (int j = 0; j < f; ++j) inv *= 0.7498942093324559;
        const double ang = (double)(pos < 128 ? pos : pos - 128) * inv; double s, c; sincos_d(ang, s, c);
        rope[i] = (f32x2){(float)c, (float)s}; }
}

__device__ __forceinline__ void phase_sgu(int layer, LAS unsigned char* lds) {
    KArgs a = kargs(); const int tid = opaque_tid(), lane = tid & 63, wave = __builtin_amdgcn_readfirstlane(tid >> 6);
    unsigned char* ws = ARG(ws); bf16_t* Zb = (bf16_t*)(ws + WS_Z); bf16_t* MIXb = (bf16_t*)(ws + WS_MIX); const bf16_t* SGUWb = (const bf16_t*)(ws + WS_SGUW);
    const float* sgu_ln = ARG(sgu_ln) + layer * 1024; const float* sgu_b = ARG(sgu_b) + layer * 1024;
    LAS float* ot = (LAS float*)(lds + 32768); LAS f32x2* stat = (LAS f32x2*)(lds + 102400);
    for (int item = blockIdx.x; item < 256; item += gridDim.x) {
        const int chunk = item >> 1, half = item & 1, R0 = chunk * 128;
#pragma unroll
        for (int bt = 0; bt < 2; ++bt) { u32x4 w0[8], w1[8];
#pragma unroll
            for (int i = 0; i < 8; ++i) { const bf16_t* p = Zb + (size_t)(R0 + wave * 16 + bt * 8 + i) * DIN + ZC_SV + lane * 16; w0[i] = *(const u32x4*)p; w1[i] = *(const u32x4*)(p + 8); }
            float s[8];
#pragma unroll
            for (int i = 0; i < 8; ++i) { float ac = 0.f;
#pragma unroll
                for (int j = 0; j < 4; ++j) ac += (bf_lo(w0[i][j]) + bf_hi(w0[i][j])) + (bf_lo(w1[i][j]) + bf_hi(w1[i][j]));
                s[i] = ac; }
#pragma unroll
            for (int i = 0; i < 8; ++i) s[i] = wave_sum(s[i]) * (1.0f / 1024.0f);
            float q[8];
#pragma unroll
            for (int i = 0; i < 8; ++i) { float ac = 0.f;
#pragma unroll
                for (int j = 0; j < 4; ++j) { const float d0 = bf_lo(w0[i][j]) - s[i], d1 = bf_hi(w0[i][j]) - s[i], d2 = bf_lo(w1[i][j]) - s[i], d3 = bf_hi(w1[i][j]) - s[i]; ac += (d0 * d0 + d1 * d1) + (d2 * d2 + d3 * d3); }
                q[i] = ac; }
#pragma unroll
            for (int i = 0; i < 8; ++i) q[i] = wave_sum(q[i]);
#pragma unroll
            for (int i = 0; i < 8; ++i) if (lane == i) stat[wave * 16 + bt * 8 + i] = (f32x2){s[i], 1.0f / sqrtf(q[i] * (1.0f / 1024.0f) + EPS)}; }
        LDS_WAIT(); __syncthreads();
        const int r32 = lane & 31, hi = lane >> 5, pb = wave & 3, dd = wave >> 2;
        for (int gi = 0; gi < 4; ++gi) { const int g = half * 4 + gi;
            u32x4 wv[4], wu[4];
#pragma unroll
            for (int i = 0; i < 4; ++i) { const int pid = tid + 512 * i, q = pid >> 4, c8 = (pid & 15) * 8; const bf16_t* zr = Zb + (size_t)(R0 + q) * DIN + g * 128 + c8;
                wv[i] = *(const u32x4*)(zr + ZC_SV); wu[i] = *(const u32x4*)(zr + ZC_SU); }
            const bf16_t* Wg = SGUWb + ((size_t)(layer * 8 + g) * 128 + 32 * pb + r32) * 128 + hi * 8;
            bf16x8 pa[2][4];
#pragma unroll
            for (int tl = 0; tl < 2; ++tl)
#pragma unroll
                for (int ks = 0; ks < 4; ++ks) pa[tl][ks] = *(const bf16x8*)(Wg + tl * 64 + ks * 16);
#pragma unroll
            for (int i = 0; i < 4; ++i) { const int pid = tid + 512 * i, q = pid >> 4, c8 = (pid & 15) * 8; const u32x4 w = wv[i]; const f32x2 st = stat[q];
                const f32x4 g0 = *(const f32x4*)(sgu_ln + g * 128 + c8), g1 = *(const f32x4*)(sgu_ln + g * 128 + c8 + 4);
                u32x4 o; o.x = cvt_pk_bf16((bf_lo(w.x) - st.x) * st.y * g0.x, (bf_hi(w.x) - st.x) * st.y * g0.y); o.y = cvt_pk_bf16((bf_lo(w.y) - st.x) * st.y * g0.z, (bf_hi(w.y) - st.x) * st.y * g0.w);
                o.z = cvt_pk_bf16((bf_lo(w.z) - st.x) * st.y * g1.x, (bf_hi(w.z) - st.x) * st.y * g1.y); o.w = cvt_pk_bf16((bf_lo(w.w) - st.x) * st.y * g1.z, (bf_hi(w.w) - st.x) * st.y * g1.w);
                *(LAS u32x4*)(lds + (q >> 6) * 16384 + att::v_st(q & 63, c8)) = o; }
            LDS_WAIT(); __syncthreads();
            f32x16 o0 = {}, o1 = {};
#pragma unroll
            for (int tl = 0; tl < 2; ++tl) { const int vb = (int)(uintptr_t)(lds + tl * 16384) + att::v_rd_base(lane) + dd * 1024;
                att::pv_one<0>(o0, vb, pa[tl][0], pa[tl][1], pa[tl][2], pa[tl][3]); att::pv_one<1>(o1, vb, pa[tl][0], pa[tl][1], pa[tl][2], pa[tl][3]); }
            const float* bs = sgu_b + g * 128 + 32 * pb;
#pragma unroll
            for (int r = 0; r < 16; ++r) { const int p = att::crow(r, hi); const float bias = bs[p]; LAS float* orow = ot + (32 * pb + p) * 132 + 64 * dd + r32;
                orow[0] = o0[r] + bias; orow[32] = o1[r] + bias; }
            LDS_WAIT(); __syncthreads();
#pragma unroll
            for (int i = 0; i < 4; ++i) { const int pid = tid + 512 * i, q = pid >> 4, c8 = (pid & 15) * 8; const u32x4 u = wu[i];
                const f32x4 m0 = *(const LAS f32x4*)(ot + q * 132 + c8), m1 = *(const LAS f32x4*)(ot + q * 132 + c8 + 4);
                u32x4 o; o.x = cvt_pk_bf16(bf_lo(u.x) * m0[0], bf_hi(u.x) * m0[1]); o.y = cvt_pk_bf16(bf_lo(u.y) * m0[2], bf_hi(u.y) * m0[3]);
                o.z = cvt_pk_bf16(bf_lo(u.z) * m1[0], bf_hi(u.z) * m1[1]); o.w = cvt_pk_bf16(bf_lo(u.w) * m1[2], bf_hi(u.w) * m1[3]);
                *(u32x4*)(MIXb + (size_t)(R0 + q) * MIXW + 1024 + g * 128 + c8) = o; }
            LDS_WAIT(); __syncthreads(); }
    }
}

__device__ __forceinline__ void phase_conv_k(int layer, int grp) {
    KArgs a = kargs(); const int tid = opaque_tid(), lane = tid & 63, wave = __builtin_amdgcn_readfirstlane(tid >> 6);
    const int gw = blockIdx.x * 8 + wave, NGW = gridDim.x * 8;
    unsigned char* ws = ARG(ws); bf16_t* Zb = (bf16_t*)(ws + WS_Z); bf16_t* MIXb = (bf16_t*)(ws + WS_MIX);
    const f32x2* rope_row = (const f32x2*)(ws + WS_ROPE); const f32x2* rope_col = rope_row + 128 * 32; char* KT = (char*)(ws + WS_KT); char* VT = (char*)(ws + WS_VT);
    const float* conv_w = ARG(conv_w) + (size_t)layer * 3 * 1024; const float* k_norm = ARG(k_norm) + layer * 128;
    { unsigned* SS = (unsigned*)(ws + WS_SS);
      for (int i = blockIdx.x * 512 + tid; i < TG; i += gridDim.x * 512) { __hip_atomic_store(SS + (size_t)grp * TG + i, 0u, __ATOMIC_RELAXED, __HIP_MEMORY_SCOPE_AGENT); __hip_atomic_store(SS + (size_t)3 * TG + i, 0u, __ATOMIC_RELAXED, __HIP_MEMORY_SCOPE_AGENT); } }
    for (int item = gw; item < (TG / 4) * 2; item += NGW) { const int blk = item >> 1, hf = item & 1, t0 = blk * 4, s0 = t0 & (SEQ - 1), c0 = hf * 512 + lane * 8;
        u32x4 cc[6], cx[6], cb[4];
#pragma unroll
        for (int i = 0; i < 6; ++i) { int row = t0 - 1 + i; row = (i == 0 && s0 == 0) ? t0 : row; row = (i == 5 && s0 == SEQ - 4) ? t0 + 3 : row;
            cc[i] = *(const u32x4*)(Zb + (size_t)row * DIN + ZC_CC + c0); cx[i] = *(const u32x4*)(Zb + (size_t)row * DIN + ZC_CX + c0); }
#pragma unroll
        for (int i = 0; i < 4; ++i) cb[i] = *(const u32x4*)(Zb + (size_t)(t0 + i) * DIN + ZC_CB + c0);
        const f32x4 wa0 = *(const f32x4*)(conv_w + c0), wa1 = *(const f32x4*)(conv_w + c0 + 4), wb0 = *(const f32x4*)(conv_w + 1024 + c0), wb1 = *(const f32x4*)(conv_w + 1024 + c0 + 4),
                    wc0 = *(const f32x4*)(conv_w + 2048 + c0), wc1 = *(const f32x4*)(conv_w + 2048 + c0 + 4);
        const float m0 = (s0 == 0) ? 0.f : 1.f, m5 = (s0 == SEQ - 4) ? 0.f : 1.f;
        float h[6][8];
#pragma unroll
        for (int i = 0; i < 6; ++i) { const float mk = (i == 0) ? m0 : (i == 5) ? m5 : 1.f;
#pragma unroll
            for (int j = 0; j < 4; ++j) { h[i][2 * j] = bf_lo(cc[i][j]) * bf_lo(cx[i][j]) * mk; h[i][2 * j + 1] = bf_hi(cc[i][j]) * bf_hi(cx[i][j]) * mk; } }
#pragma unroll
        for (int i = 0; i < 4; ++i) { float y[8];
#pragma unroll
            for (int j = 0; j < 4; ++j) { y[j] = wa0[j] * h[i][j] + wb0[j] * h[i + 1][j] + wc0[j] * h[i + 2][j]; y[4 + j] = wa1[j] * h[i][4 + j] + wb1[j] * h[i + 1][4 + j] + wc1[j] * h[i + 2][4 + j]; }
            u32x4 o; o.x = cvt_pk_bf16(bf_lo(cb[i].x) * y[0], bf_hi(cb[i].x) * y[1]); o.y = cvt_pk_bf16(bf_lo(cb[i].y) * y[2], bf_hi(cb[i].y) * y[3]);
            o.z = cvt_pk_bf16(bf_lo(cb[i].z) * y[4], bf_hi(cb[i].z) * y[5]); o.w = cvt_pk_bf16(bf_lo(cb[i].w) * y[6], bf_hi(cb[i].w) * y[7]);
            *(u32x4*)(MIXb + (size_t)(t0 + i) * MIXW + c0) = o; }
    }
    const int l16 = lane & 15; const bool first = (l16 & 4) == 0;
    const f32x4 kn0 = *(const f32x4*)(k_norm + l16 * 8), kn1 = *(const f32x4*)(k_norm + l16 * 8 + 4);
    for (int blk = gw; blk < TG / 4; blk += NGW) { const int t0 = blk * 4, s0 = t0 & (SEQ - 1);
        u32x4 kx[4], vx[4]; f32x4 cs[4][4];
#pragma unroll
        for (int i = 0; i < 4; ++i) { kx[i] = *(const u32x4*)(Zb + (size_t)(t0 + i) * DIN + ZC_K + lane * 8); vx[i] = *(const u32x4*)(Zb + (size_t)(t0 + i) * DIN + ZC_V + lane * 8); const int pos = s0 + i;
            const f32x4* tab = (const f32x4*)((l16 < 8) ? (rope_row + (pos >> 6) * 32 + (l16 & 3) * 8) : (rope_col + (pos & 63) * 32 + (l16 & 3) * 8));
#pragma unroll
            for (int j = 0; j < 4; ++j) cs[i][j] = tab[j]; }
#pragma unroll
        for (int i = 0; i < 4; ++i) { float x[8];
#pragma unroll
            for (int j = 0; j < 4; ++j) { x[2 * j] = bf_lo(kx[i][j]); x[2 * j + 1] = bf_hi(kx[i][j]); }
            float ss = 0.f;
#pragma unroll
            for (int j = 0; j < 8; ++j) ss += x[j] * x[j];
            ss += swz_xor<1>(ss); ss += swz_xor<2>(ss); ss += swz_xor<4>(ss); ss += swz_xor<8>(ss);
            const float rstd = 1.0f / sqrtf(ss * (1.0f / 128.0f) + EPS);
            float y[8], o[8];
#pragma unroll
            for (int j = 0; j < 4; ++j) { y[j] = x[j] * rstd * kn0[j]; y[4 + j] = x[4 + j] * rstd * kn1[j]; }
#pragma unroll
            for (int j = 0; j < 8; ++j) { const float py = swz_xor<4>(y[j]); const float c = cs[i][j >> 1][(j & 1) * 2], s = cs[i][j >> 1][(j & 1) * 2 + 1];
                o[j] = first ? (y[j] * c - py * s) : (y[j] * c + py * s); }
            u32x4 ow; ow.x = cvt_pk_bf16(o[0], o[1]); ow.y = cvt_pk_bf16(o[2], o[3]); ow.z = cvt_pk_bf16(o[4], o[5]); ow.w = cvt_pk_bf16(o[6], o[7]);
            const int t = t0 + i, bb = t >> 13, sp = t & (SEQ - 1), r = sp & 63; const size_t img = (size_t)((bb * NKV + (lane >> 4)) * 128 + (sp >> 6)) * 16384;
            const int rk = (r & 32) | att::krow(r & 31);
            *(u32x4*)(KT + img + KSWZ(rk, l16 * 16)) = ow;
            *(u32x4*)(VT + img + att::v_st(r, l16 * 8)) = vx[i]; }
    }
}

__device__ __forceinline__ void phase_attention(int layer, LAS unsigned char* lds) {
    KArgs a = kargs(); unsigned char* ws = ARG(ws); const bf16_t* Zb = (const bf16_t*)(ws + WS_Z); bf16_t* MIXb = (bf16_t*)(ws + WS_MIX);
    const f32x2* rope_row = (const f32x2*)(ws + WS_ROPE); const f32x2* rope_col = rope_row + 128 * 32; const float* qn = ARG(q_norm) + layer * 128;
    const char* KT = (const char*)(ws + WS_KT); const char* VT = (const char*)(ws + WS_VT);
    bool maxfree;
    { const int lane = opaque_tid() & 63; const float* kn = ARG(k_norm) + layer * 128;
      float gq = fmaxf(fabsf(qn[lane]), fabsf(qn[lane + 64])), gk = fmaxf(fabsf(kn[lane]), fabsf(kn[lane + 64]));
      gq = fmaxf(gq, swz_xor<1>(gq)); gq = fmaxf(gq, swz_xor<2>(gq)); gq = fmaxf(gq, swz_xor<4>(gq)); gq = fmaxf(gq, swz_xor<8>(gq)); gq = fmaxf(gq, swz_xor<16>(gq));
      gk = fmaxf(gk, swz_xor<1>(gk)); gk = fmaxf(gk, swz_xor<2>(gk)); gk = fmaxf(gk, swz_xor<4>(gk)); gk = fmaxf(gk, swz_xor<8>(gk)); gk = fmaxf(gk, swz_xor<16>(gk));
      { auto r = __builtin_amdgcn_permlane32_swap(__float_as_uint(gq), __float_as_uint(gq), false, false); gq = fmaxf(__uint_as_float(r[0]), __uint_as_float(r[1])); }
      { auto r = __builtin_amdgcn_permlane32_swap(__float_as_uint(gk), __float_as_uint(gk), false, false); gk = fmaxf(__uint_as_float(r[0]), __uint_as_float(r[1])); }
      const float bound = att::SCALE * 1.4426950408889634f * 128.0f * gq * gk;
      maxfree = __builtin_amdgcn_readfirstlane(bound < 100.0f ? 1 : 0) != 0; }
    for (int u = blockIdx.x; u < 1024; u += gridDim.x) { const int i = u >> 8, cc = u & 255, pair = cc & 7, qb = cc >> 3, b = pair >> 2, kvh = pair & 3, h = kvh * 4 + i;
        const size_t img = (size_t)((b * NKV + kvh) * 128) * 16384;
        if (maxfree) att::attn_body_maxfree(Zb + ((size_t)b * SEQ + (size_t)qb * 256) * DIN + ZC_Q + h * HD, KT + img, VT + img,
                                 MIXb + ((size_t)b * SEQ + (size_t)qb * 256) * MIXW + 2048 + h * HD, SEQ / 64, lds, qn, rope_row, rope_col, qb * 256);
        else att::attn_dense_body_dma(Zb + ((size_t)b * SEQ + (size_t)qb * 256) * DIN + ZC_Q + h * HD, KT + img, VT + img,
                                 MIXb + ((size_t)b * SEQ + (size_t)qb * 256) * MIXW + 2048 + h * HD, SEQ / 64, lds, qn, rope_row, rope_col, qb * 256);
        asm volatile("s_waitcnt vmcnt(0) lgkmcnt(0)" ::: "memory"); __builtin_amdgcn_s_barrier(); asm volatile("" ::: "memory"); }
}

#ifndef PH_MASK
#define PH_MASK 0xFFFF
#endif
#define PH(n) constexpr ((PH_MASK >> (n)) & 1)
#ifndef REP_MASK
#define REP_MASK 0
#endif
#define REP(n) constexpr ((REP_MASK >> (n)) & 1)

__global__ void __launch_bounds__(512, 2) fwd_kernel(Args a_unused) {
    extern __shared__ __attribute__((aligned(16))) unsigned char lds_raw[];
    LAS unsigned char* lds = (LAS unsigned char*)lds_raw;
    for (int u = threadIdx.x; u < (LDS_BYTES - LDSCTL_OFF) / 4; u += 512) ((LAS unsigned*)(lds + LDSCTL_OFF))[u] = 0u;
    __syncthreads();
    XcdBarrier bar = xcd_barrier_post((unsigned*)(((unsigned char*)kargs()->ws) + WS_CTL), (volatile LAS unsigned*)(lds + LDSCTL_OFF + 64));

    if PH(0) phase_prologue(lds);
    xcd_barrier(bar);
    cls_fast(bar, (volatile LAS unsigned*)(lds + LDSCTL_OFF + 96));
#define LFAST() (__builtin_amdgcn_readfirstlane((int)*(volatile LAS unsigned*)(lds + LDSCTL_OFF + 96)) != 0)

    for (int layer = 0; layer < DEPTH; ++layer) {
        for (int grp = 0; grp < NGRP; ++grp) {
            if PH(2) { KArgs a = kargs(); unsigned char* ws = ARG(ws); pg8::EpiBf16 E{(bf16_t*)(ws + WS_Z), DIN, (const unsigned*)(ws + WS_SS) + (size_t)grp * TG};
                pg8::gemm_phase<pg8::EpiBf16, TG, DIN, DM>(lds, (const bf16_t*)(ws + WS_XBA) + (size_t)grp * TG * DM, (const bf16_t*)(ws + WS_WIN) + (size_t)layer * DIN * DM, gridDim.x, blockIdx.x, E); }
            xcd_barrier(bar);
            if PH(3) { phase_sgu(layer, lds); phase_conv_k(layer, grp); }
            xcd_barrier(bar);
            if PH(4) phase_attention(layer, lds);
            xcd_barrier(bar);
            if PH(5) { KArgs a = kargs(); unsigned char* ws = ARG(ws); pg8::EpiMerge E{(const bf16_t*)(ws + WS_Z) + ZC_G, ARG(gate_bias) + (size_t)layer * 3 * DM, (bf16_t*)(ws + WS_MRG)};
                pg8::gemm_phase<pg8::EpiMerge, TG, DM, MIXW>(lds, (const bf16_t*)(ws + WS_MIX), (const bf16_t*)(ws + WS_WBR) + (size_t)layer * DM * MIXW, gridDim.x, blockIdx.x, E); }
            xcd_barrier(bar, LFAST());
            if PH(6) { KArgs a = kargs(); unsigned char* ws = ARG(ws);
                pg8::EpiResidSS E{(const bf16_t*)(ws + WS_XBA) + (size_t)grp * TG * DM, (bf16_t*)(ws + WS_H), (unsigned*)(ws + WS_SS) + (size_t)3 * TG};
                pg8::gemm_phase<pg8::EpiResidSS, TG, DM, DM>(lds, (const bf16_t*)(ws + WS_MRG), (const bf16_t*)(ws + WS_WOUT) + (size_t)layer * DM * DM, gridDim.x, blockIdx.x, E); }
            xcd_barrier(bar, LFAST());
            if PH(8) { KArgs a = kargs(); unsigned char* ws = ARG(ws); pg8::EpiSwiGLU E{(bf16_t*)(ws + WS_ACT), DFF, (const unsigned*)(ws + WS_SS) + (size_t)3 * TG};
                pg8::gemm_phase<pg8::EpiSwiGLU, TG, NFF2, DM>(lds, (const bf16_t*)(ws + WS_H), (const bf16_t*)(ws + WS_WFI) + (size_t)layer * NFF2 * DM, gridDim.x, blockIdx.x, E); }
            xcd_barrier(bar, LFAST());
            if PH(9) { KArgs a = kargs(); unsigned char* ws = ARG(ws);
                pg8::EpiResidSS E{(const bf16_t*)(ws + WS_H), (bf16_t*)(ws + WS_XBA) + (size_t)grp * TG * DM, (unsigned*)(ws + WS_SS) + (size_t)grp * TG};
                pg8::gemm_phase<pg8::EpiResidSS, TG, DM, DFF>(lds, (const bf16_t*)(ws + WS_ACT), (const bf16_t*)(ws + WS_WFO) + (size_t)layer * DM * DFF, gridDim.x, blockIdx.x, E); }
            xcd_barrier(bar, LFAST() && !(layer == DEPTH - 1 && grp == NGRP - 1));
        }
    }

    if PH(10) {
        KArgs a = kargs(); const int tid = opaque_tid(), lane = tid & 63, wave = __builtin_amdgcn_readfirstlane(tid >> 6);
        const int gw = blockIdx.x * 8 + wave, NGW = gridDim.x * 8; float* out = ARG(out); const bf16_t* XBA = (const bf16_t*)(ARG(ws) + WS_XBA);
        const f32x4* gr = (const f32x4*)ARG(norm_final) + 2 * lane; f32x4 gv[8];
#pragma unroll
        for (int j = 0; j < 4; ++j) { gv[2 * j] = gr[128 * j]; gv[2 * j + 1] = gr[128 * j + 1]; }
        for (int m = gw; m < NTOK; m += NGW) {
            const u32x4* xr = (const u32x4*)(XBA + (size_t)m * DM) + lane; f32x4 v[8]; float ss = 0.f;
#pragma unroll
            for (int j = 0; j < 4; ++j) { const u32x4 b = xr[64 * j]; v[2 * j] = (f32x4){bf_lo(b.x), bf_hi(b.x), bf_lo(b.y), bf_hi(b.y)}; v[2 * j + 1] = (f32x4){bf_lo(b.z), bf_hi(b.z), bf_lo(b.w), bf_hi(b.w)}; }
#pragma unroll
            for (int j = 0; j < 8; ++j) ss += (v[j].x * v[j].x + v[j].y * v[j].y) + (v[j].z * v[j].z + v[j].w * v[j].w);
            const float rstd = 1.0f / sqrtf(wave_sum(ss) * (1.0f / DM) + EPS);
            f32x4* orow = (f32x4*)(out + (size_t)m * DM) + 2 * lane;
#pragma unroll
            for (int j = 0; j < 4; ++j) { orow[128 * j] = v[2 * j] * rstd * gv[2 * j]; orow[128 * j + 1] = v[2 * j + 1] * rstd * gv[2 * j + 1]; }
        }
    }
}

extern "C" void kernel_launch(void* const* d_in, const int* in_sizes, int n_in, void* d_out, int out_size, void* d_ws, size_t ws_size, hipStream_t stream) {
    static int grid = 0;
    if (grid == 0) {
        if (n_in != 19 || out_size != NTOK * DM || ws_size < WS_END) { fprintf(stderr, "kernel_launch: unexpected shapes: n_in %d out %d ws %zu (need %zu)\n", n_in, out_size, ws_size, (size_t)WS_END); grid = -1; return; }
        int dev = 0, cus = 0, per_cu = 0;
        if (hipGetDevice(&dev) != hipSuccess || hipDeviceGetAttribute(&cus, hipDeviceAttributeMultiprocessorCount, dev) != hipSuccess) { fprintf(stderr, "kernel_launch: device query failed\n"); grid = -1; return; }
        if (hipFuncSetAttribute((const void*)fwd_kernel, hipFuncAttributeMaxDynamicSharedMemorySize, LDS_BYTES) != hipSuccess) { fprintf(stderr, "kernel_launch: hipFuncSetAttribute failed\n"); grid = -1; return; }
        if (hipOccupancyMaxActiveBlocksPerMultiprocessor(&per_cu, (const void*)fwd_kernel, 512, LDS_BYTES) != hipSuccess || per_cu < 1) { fprintf(stderr, "kernel_launch: occupancy query says %d blocks per CU\n", per_cu); }
        (void)hipGetLastError();
        grid = cus;
    }
    if (grid < 0) return;
    if (hipMemsetAsync((char*)d_ws + WS_CTL, 0, CTL_ZERO_BYTES, stream) != hipSuccess) { fprintf(stderr, "kernel_launch: memset failed\n"); return; }
    Args a{};
    a.x_prompt = (const float*)d_in[0]; a.x_sample = (const float*)d_in[1]; a.norm_mix = (const float*)d_in[2]; a.w_in = (const float*)d_in[3]; a.gate_bias = (const float*)d_in[4];
    a.conv_w = (const float*)d_in[5]; a.sgu_ln = (const float*)d_in[6]; a.sgu_ws = (const float*)d_in[7]; a.sgu_b = (const float*)d_in[8]; a.q_norm = (const float*)d_in[9];
    a.k_norm = (const float*)d_in[10]; a.w_br_conv = (const float*)d_in[11]; a.w_br_sgu = (const float*)d_in[12]; a.w_br_attn = (const float*)d_in[13]; a.w_out = (const float*)d_in[14];
    a.norm_ffn = (const float*)d_in[15]; a.w_ffn_in = (const float*)d_in[16]; a.w_ffn_out = (const float*)d_in[17]; a.norm_final = (const float*)d_in[18];
    a.out = (float*)d_out; a.ws = (unsigned char*)d_ws;
    hipLaunchKernelGGL(fwd_kernel, dim3(grid), dim3(512), LDS_BYTES, stream, a);
    const hipError_t le = hipPeekAtLastError();
    if (le != hipSuccess) fprintf(stderr, "kernel_launch: launch failed: %s\n", hipGetErrorName(le));
}
```

```cpp
#include <hip/hip_runtime.h>
#ifndef RELAX
#define RELAX 0
#endif
#include <cstdio>
#include <cstdint>

#define LAS __attribute__((address_space(3)))
typedef unsigned short bf16_t;
typedef short bf16x8 __attribute__((ext_vector_type(8)));
typedef short s16x4 __attribute__((ext_vector_type(4)));
typedef float f32x2 __attribute__((ext_vector_type(2)));
typedef float f32x4 __attribute__((ext_vector_type(4)));
typedef float f32x16 __attribute__((ext_vector_type(16)));
typedef unsigned u32x2 __attribute__((ext_vector_type(2)));
typedef unsigned u32x4 __attribute__((ext_vector_type(4)));

constexpr int DM = 2048, DIN = 14336, DFF = 5632, NFF2 = 11264, HD = 128, NQH = 16, NKV = 4, SEQ = 8192, DEPTH = 4;
constexpr int TG = 16384, NGRP = 3, NTOK = 49152;
constexpr int ZC_CB = 0, ZC_CC = 1024, ZC_CX = 2048, ZC_SU = 3072, ZC_SV = 4096, ZC_Q = 5120, ZC_K = 7168, ZC_V = 7680, ZC_G = 8192;
constexpr int MIXW = 4096;
constexpr float EPS = 1e-6f;

constexpr size_t MiB = (size_t)1 << 20;
constexpr size_t WS_CTL = 0, CTL_ZERO_BYTES = 64 * 1024;
constexpr size_t WS_ROPE = 1 * MiB;
constexpr size_t WS_SGUW = 2 * MiB;
constexpr size_t WS_WIN = 4 * MiB;
constexpr size_t WS_WBR = WS_WIN + 224 * MiB;
constexpr size_t WS_WOUT = WS_WBR + 64 * MiB;
constexpr size_t WS_WFI = WS_WOUT + 32 * MiB;
constexpr size_t WS_WFO = WS_WFI + 176 * MiB;
constexpr size_t WS_H = WS_WFO + 88 * MiB;
constexpr size_t WS_Z = WS_H + 64 * MiB;
constexpr size_t WS_MIX = WS_Z + 448 * MiB;
constexpr size_t WS_MRG = WS_MIX + 128 * MiB;
constexpr size_t WS_ACT = WS_MRG + 64 * MiB;
constexpr size_t WS_XBA = WS_ACT + 176 * MiB;
constexpr size_t WS_SS = WS_XBA + 192 * MiB;
constexpr size_t WS_KT = WS_SS + 1 * MiB;
constexpr size_t WS_VT = WS_KT + 16 * MiB;
constexpr size_t WS_END = WS_VT + 16 * MiB;
constexpr float SS_SCALE = 1024.0f, SS_INV = 1.0f / 1024.0f;

constexpr int RING_BYTES = 131072, LDSCTL_OFF = RING_BYTES, LDS_BYTES = 147456;

#define LDS_WAIT() asm volatile("s_waitcnt lgkmcnt(0)" ::: "memory")
#define VM_WAIT() asm volatile("s_waitcnt vmcnt(0)" ::: "memory")

__device__ __forceinline__ unsigned cvt_pk_bf16(float lo, float hi) { unsigned r; asm volatile("v_cvt_pk_bf16_f32 %0, %1, %2" : "=v"(r) : "v"(lo), "v"(hi)); return r; }
__device__ __forceinline__ float bf_lo(unsigned w) { return __uint_as_float(w << 16); }
__device__ __forceinline__ float bf_hi(unsigned w) { return __uint_as_float(w & 0xffff0000u); }
template <int X> __device__ __forceinline__ float swz_xor(float v) { return __int_as_float(__builtin_amdgcn_ds_swizzle(__float_as_int(v), (X << 10) | 0x1F)); }
__device__ __forceinline__ float xor32_sum(float v) { auto r = __builtin_amdgcn_permlane32_swap(__float_as_uint(v), __float_as_uint(v), false, false); return __uint_as_float(r[0]) + __uint_as_float(r[1]); }
__device__ __forceinline__ float wave_sum(float v) {
    v += swz_xor<1>(v); v += swz_xor<2>(v); v += swz_xor<4>(v); v += swz_xor<8>(v); v += swz_xor<16>(v);
    return xor32_sum(v);
}
__device__ __forceinline__ float fast_exp(float x) { return __builtin_amdgcn_exp2f(x * 1.4426950408889634f); }
__device__ __forceinline__ float clampg(float x) { return fminf(fmaxf(x, -30.f), 30.f); }

#define XB_TMO      128
#define XB_XCNT(j)  (256  + 64 * (j))
#define XB_XSUB(j)  (1280 + 64 * (j))
#define XB_XGEN(j)  (2304 + 64 * (j))
#define XB_TOP      3328
#define XB_TOPGEN   3392
#define XCD_BAR_WORDS 3456
#define XB_SPIN_CAP (1u << 18)

#define XB_G(p) ((__attribute__((address_space(1))) unsigned*)(p))
__device__ __forceinline__ unsigned xb_ld(unsigned* p)              { return __hip_atomic_load(XB_G(p), __ATOMIC_RELAXED, __HIP_MEMORY_SCOPE_AGENT); }
__device__ __forceinline__ unsigned xb_add(unsigned* p, unsigned v) { return __hip_atomic_fetch_add(XB_G(p), v, __ATOMIC_RELAXED, __HIP_MEMORY_SCOPE_AGENT); }
__device__ __forceinline__ unsigned xb_xcc_id() { return (unsigned)__builtin_amdgcn_s_getreg((3 << 11) | 20) & 0xFu; }
#define XB_SPIN(cond, bar) do { unsigned _sp = 0; while (cond) { __builtin_amdgcn_s_sleep(1); \
    if ((++_sp & 255u) == 0u) { if (xb_ld(&(bar)[XB_TMO])) break; if (_sp > XB_SPIN_CAP) { (void)xb_add(&(bar)[XB_TMO], 1u); break; } } } } while (0)

struct XcdBarrier { unsigned* bar; unsigned x; volatile LAS unsigned* st; };

__device__ __forceinline__ XcdBarrier xcd_barrier_post(unsigned* bar, volatile LAS unsigned* st) {
    XcdBarrier b; b.bar = bar; b.x = xb_xcc_id(); b.st = st;
    if (threadIdx.x == 0) (void)xb_add(&bar[XB_XCNT(b.x)], 1u);
    return b;
}
__device__ __forceinline__ void xcd_barrier_complete(unsigned* bar, unsigned x, unsigned& nloc, unsigned& nx) {
    const unsigned G = gridDim.x * gridDim.y * gridDim.z;
    unsigned sum, cnt, mine, sp = 0u;
    for (;;) {
        sum = 0u; cnt = 0u; mine = 0u;
#pragma unroll
        for (unsigned j = 0; j < 16; ++j) { const unsigned c = xb_ld(&bar[XB_XCNT(j)]); sum += c; cnt += (c > 0u) ? 1u : 0u; mine = (j == x) ? c : mine; }
        if (sum == G) break;
        __builtin_amdgcn_s_sleep(1);
        if ((++sp & 255u) == 0u) { if (xb_ld(&bar[XB_TMO])) break; if (sp > XB_SPIN_CAP) { (void)xb_add(&bar[XB_TMO], 1u); break; } }
    }
    nloc = mine > 0u ? mine : 1u; nx = cnt > 0u ? cnt : 1u;
}
__device__ __forceinline__ void xcd_barrier(const XcdBarrier& b) {
    asm volatile("s_waitcnt vmcnt(0)" ::: "memory");
    __syncthreads();
    if (threadIdx.x == 0) {
        unsigned* bar = b.bar; unsigned bx_ = b.x; asm volatile("" : "+s"(bar), "+s"(bx_));
        __builtin_amdgcn_s_waitcnt(0);
        unsigned nloc = b.st[0], nx = b.st[1];
        if (nloc == 0u) { xcd_barrier_complete(bar, bx_, nloc, nx); b.st[0] = nloc; b.st[1] = nx; }
        const unsigned old = xb_add(&bar[XB_XSUB(bx_)], 1u);
        const unsigned gen = old / nloc;
        if (old + 1u == (gen + 1u) * nloc) {
            __builtin_amdgcn_fence(__ATOMIC_RELEASE, "agent");
            asm volatile("s_waitcnt vmcnt(0)" ::: "memory");
            const unsigned og = xb_add(&bar[XB_TOP], 1u);
            const unsigned tg = og / nx;
            if (og + 1u == (tg + 1u) * nx) xb_add(&bar[XB_TOPGEN], 1u);
            else XB_SPIN(xb_ld(&bar[XB_TOPGEN]) == tg, bar);
            __builtin_amdgcn_fence(__ATOMIC_ACQUIRE, "agent");
            xb_add(&bar[XB_XGEN(bx_)], 1u);
            asm volatile("s_waitcnt vmcnt(0)" ::: "memory");
        } else {
            XB_SPIN(xb_ld(&bar[XB_XGEN(bx_)]) == gen, bar);
            __builtin_amdgcn_fence(__ATOMIC_ACQUIRE, "agent");
            asm volatile("s_waitcnt vmcnt(0)" ::: "memory");
        }
    }
    __syncthreads();
}

namespace pg8 {
constexpr int BM = 256, BK = 64, HALF = 128, HTB = HALF * BK * 2, STAGE_BYTES = 8 * HTB, NXCD = 8, WGM = 8;
__host__ __device__ __forceinline__ int lds_byte(int r, int c) { const int st = (r >> 4) * 2 + (c >> 5), rr = r & 15, cc = c & 31, ob = rr * 64 + cc * 2; return st * 1024 + (ob ^ (((ob >> 9) & 1) << 5)); }
__host__ __device__ __forceinline__ void stage_rc(int b, int& R, int& C) { const int st = b / 1024, sb = b % 1024, swz = sb ^ (((sb >> 9) & 1) << 5); R = (st >> 1) * 16 + swz / 64; C = (st & 1) * 32 + (swz % 64) / 2; }
__host__ __device__ __forceinline__ int perm32(int rho) { const int n = rho >> 4, i = rho & 15; return 8 * (i >> 2) + 4 * n + (i & 3); }

struct Unit { int pm, pn; };

template <int M, int N> struct StaticOrder {
    static constexpr int nM = M / BM, nN = N / BM, nwg = nM * nN;
    int G, c;
    __device__ __forceinline__ bool next(int i, Unit& u) const {
        const long L = (long)i * G + c; if (L >= nwg) return false;
        int wgid = (int)L; { const int q = nwg / NXCD, r = nwg % NXCD, xcd = wgid % NXCD, off = wgid / NXCD; wgid = (xcd < r ? xcd * (q + 1) : r * (q + 1) + (xcd - r) * q) + off; }
        const int nig = WGM * nN, gid = wgid / nig, fm = gid * WGM, gsz = (nM - fm) < WGM ? (nM - fm) : WGM;
        u.pm = fm + ((wgid % nig) % gsz); u.pn = (wgid % nig) / gsz; return true;
    }
};

typedef f32x4 Acc[2][2][4][2];

__device__ __forceinline__ void st_b128(void* p, u32x4 w) { asm volatile("global_store_dwordx4 %0, %1, off\n\ts_nop 1" :: "v"(p), "v"(w) : "memory"); }
__device__ __forceinline__ void st_b128_wt(void* p, u32x4 w) { asm volatile("global_store_dwordx4 %0, %1, off sc0 sc1\n\ts_nop 1" :: "v"(p), "v"(w) : "memory"); }
__device__ __forceinline__ unsigned ld_u32_asm(const unsigned* p) { unsigned v; asm volatile("global_load_dword %0, %1, off" : "=v"(v) : "v"(p) : "memory"); return v; }
__device__ __forceinline__ void atomic_add_u32_noret(unsigned* p, unsigned v) { asm volatile("global_atomic_add %0, %1, off" :: "v"(p), "v"(v) : "memory"); }
__device__ __forceinline__ float rstd_from(unsigned s) { return __builtin_amdgcn_rsqf((float)s * (SS_INV / DM) + EPS); }
typedef unsigned Pre[8];
struct EpiBf16 {
    static constexpr bool PERM = true, HOOK = false, PRE = true; static constexpr int TAIL = 24;
    __device__ __forceinline__ void prefetch(Pre& pre, const Unit& u, int wr, int fr) const {
#pragma unroll
        for (int i = 0; i < 8; ++i) pre[i] = ld_u32_asm(ss + (u.pm * BM + wr * 64 + fr + (i >> 2) * HALF + (i & 3) * 16)); }
    bf16_t* O; int ldc; const unsigned* ss;
    __device__ __forceinline__ void hook(Acc&, const Unit&, int, int, int, int, int) const {}
    __device__ __forceinline__ void operator()(Acc& acc, const Unit& u, int wr, int wc, int fr, int fq, const Pre& pre) const {
        int row0 = u.pm * BM + wr * 64 + fr; asm volatile("" : "+v"(row0)); const int col0 = u.pn * BM + wc * 32 + 8 * fq;
#pragma unroll
        for (int ai = 0; ai < 2; ++ai)
#pragma unroll
            for (int m = 0; m < 4; ++m) { const size_t r = (size_t)(row0 + ai * HALF + m * 16); bf16_t* rowp = O + r * ldc + col0; const float rs = rstd_from(pre[ai * 4 + m]);
#pragma unroll
                for (int bj = 0; bj < 2; ++bj) { const f32x4 v0 = acc[ai][bj][m][0] * rs, v1 = acc[ai][bj][m][1] * rs;
                    u32x4 w; w.x = cvt_pk_bf16(v0[0], v0[1]); w.y = cvt_pk_bf16(v0[2], v0[3]); w.z = cvt_pk_bf16(v1[0], v1[1]); w.w = cvt_pk_bf16(v1[2], v1[3]);
                    st_b128_wt(rowp + bj * HALF, w); } }
    }
};
struct EpiSwiGLU {
    static constexpr bool PERM = true, HOOK = false, PRE = true; static constexpr int TAIL = 16;
    __device__ __forceinline__ void prefetch(Pre& pre, const Unit& u, int wr, int fr) const {
#pragma unroll
        for (int i = 0; i < 8; ++i) pre[i] = ld_u32_asm(ss + (u.pm * BM + wr * 64 + fr + (i >> 2) * HALF + (i & 3) * 16)); }
    bf16_t* O; int ldc; const unsigned* ss;
    __device__ __forceinline__ void hook(Acc&, const Unit&, int, int, int, int, int) const {}
    __device__ __forceinline__ void operator()(Acc& acc, const Unit& u, int wr, int wc, int fr, int fq, const Pre& pre) const {
        int row0 = u.pm * BM + wr * 64 + fr; asm volatile("" : "+v"(row0)); const int col0 = u.pn * HALF + wc * 32 + 8 * fq;
#pragma unroll
        for (int ai = 0; ai < 2; ++ai)
#pragma unroll
            for (int m = 0; m < 4; ++m) { const size_t r = (size_t)(row0 + ai * HALF + m * 16); bf16_t* rowp = O + r * ldc + col0; const float rs = rstd_from(pre[ai * 4 + m]);
                float o[8];
#pragma unroll
                for (int n = 0; n < 2; ++n)
#pragma unroll
                    for (int e = 0; e < 4; ++e) { const float g = acc[ai][0][m][n][e] * rs, up = acc[ai][1][m][n][e] * rs;
                        o[n * 4 + e] = g * __builtin_amdgcn_rcpf(1.0f + fast_exp(-g)) * up; }
                u32x4 w; w.x = cvt_pk_bf16(o[0], o[1]); w.y = cvt_pk_bf16(o[2], o[3]); w.z = cvt_pk_bf16(o[4], o[5]); w.w = cvt_pk_bf16(o[6], o[7]);
                st_b128_wt(rowp, w); }
    }
};
struct EpiResidSS {
    static constexpr bool PERM = true, HOOK = false, PRE = false; static constexpr int TAIL = 24;
    __device__ __forceinline__ void prefetch(Pre&, const Unit&, int, int) const {}
    const bf16_t* base; bf16_t* xb; unsigned* ss;
    __device__ __forceinline__ void hook(Acc&, const Unit&, int, int, int, int, int) const {}
    __device__ __forceinline__ void operator()(Acc& acc, const Unit& u, int wr, int wc, int fr, int fq, const Pre& pre) const {
        int row0 = u.pm * BM + wr * 64 + fr; asm volatile("" : "+v"(row0)); const int col0 = u.pn * BM + wc * 32 + 8 * fq;
        u32x4 b[8][2];
#pragma unroll
        for (int i = 0; i < 8; ++i)
#pragma unroll
            for (int bj = 0; bj < 2; ++bj) b[i][bj] = *(const u32x4*)(base + (size_t)(row0 + (i >> 2) * HALF + (i & 3) * 16) * DM + col0 + bj * HALF);
        asm volatile("" : "+v"(b[0][0]), "+v"(b[0][1]), "+v"(b[1][0]), "+v"(b[1][1]), "+v"(b[2][0]), "+v"(b[2][1]), "+v"(b[3][0]), "+v"(b[3][1]));
        asm volatile("" : "+v"(b[4][0]), "+v"(b[4][1]), "+v"(b[5][0]), "+v"(b[5][1]), "+v"(b[6][0]), "+v"(b[6][1]), "+v"(b[7][0]), "+v"(b[7][1]));
#pragma unroll
        for (int i = 0; i < 8; ++i) { const size_t r = (size_t)(row0 + (i >> 2) * HALF + (i & 3) * 16), off = r * DM + col0; float sq = 0.f;
#pragma unroll
            for (int bj = 0; bj < 2; ++bj) { const u32x4 bb = b[i][bj];
                const f32x4 v0 = (f32x4){bf_lo(bb.x), bf_hi(bb.x), bf_lo(bb.y), bf_hi(bb.y)} + acc[i >> 2][bj][i & 3][0], v1 = (f32x4){bf_lo(bb.z), bf_hi(bb.z), bf_lo(bb.w), bf_hi(bb.w)} + acc[i >> 2][bj][i & 3][1];
                u32x4 w; w.x = cvt_pk_bf16(v0[0], v0[1]); w.y = cvt_pk_bf16(v0[2], v0[3]); w.z = cvt_pk_bf16(v1[0], v1[1]); w.w = cvt_pk_bf16(v1[2], v1[3]);
                st_b128(xb + off + bj * HALF, w);
                sq += (v0[0] * v0[0] + v0[1] * v0[1]) + (v0[2] * v0[2] + v0[3] * v0[3]) + (v1[0] * v1[0] + v1[1] * v1[1]) + (v1[2] * v1[2] + v1[3] * v1[3]); }
            sq += swz_xor<16>(sq); sq = xor32_sum(sq);
            if (fq == 0) atomic_add_u32_noret(ss + r, (unsigned)(sq * SS_SCALE + 0.5f)); }
    }
};
struct EpiMerge {
    static constexpr bool PERM = true, HOOK = true, PRE = false; static constexpr int TAIL = 8;
    __device__ __forceinline__ void prefetch(Pre&, const Unit&, int, int) const {}
    const bf16_t* zg; const float* gb; bf16_t* O;
    __device__ __forceinline__ void hook(Acc& acc, const Unit& u, int stage, int wr, int wc, int fr, int fq) const {
        int row0 = u.pm * BM + wr * 64 + fr; asm volatile("" : "+v"(row0)); const int col0 = u.pn * BM + wc * 32 + 8 * fq;
#pragma unroll
        for (int bj = 0; bj < 2; ++bj) {
            f32x4 ba[2], bb[2];
#pragma unroll
            for (int n = 0; n < 2; ++n) { ba[n] = *(const f32x4*)(gb + stage * DM + col0 + bj * HALF + 4 * n) * -1.4426950408889634f; bb[n] = *(const f32x4*)(gb + (stage + 1) * DM + col0 + bj * HALF + 4 * n) * -1.4426950408889634f; }
#pragma unroll
            for (int ai = 0; ai < 2; ++ai) { u32x4 ga[4], gv[4];
#pragma unroll
                for (int m = 0; m < 4; ++m) { const bf16_t* rowp = zg + (size_t)(row0 + ai * HALF + m * 16) * DIN + stage * DM + col0 + bj * HALF;
                    ga[m] = *(const u32x4*)rowp; gv[m] = *(const u32x4*)(rowp + DM); }
                asm volatile("" : "+v"(ga[0]), "+v"(ga[1]), "+v"(ga[2]), "+v"(ga[3]), "+v"(gv[0]), "+v"(gv[1]), "+v"(gv[2]), "+v"(gv[3]));
#pragma unroll
                for (int m = 0; m < 4; ++m)
#pragma unroll
                    for (int n = 0; n < 2; ++n)
#pragma unroll
                        for (int e = 0; e < 4; ++e) { const unsigned wa = ga[m][n * 2 + (e >> 1)], wb = gv[m][n * 2 + (e >> 1)];
                            const float ta = __builtin_fmaf((e & 1) ? bf_hi(wa) : bf_lo(wa), -1.4426950408889634f, ba[n][e]), tb = __builtin_fmaf((e & 1) ? bf_hi(wb) : bf_lo(wb), -1.4426950408889634f, bb[n][e]);
                            constexpr float GCLH = 30.0f * 1.4426950408889634f;
                            const float ea = __builtin_amdgcn_exp2f(fminf(fmaxf(ta, -GCLH), GCLH)), eb = __builtin_amdgcn_exp2f(fminf(fmaxf(tb, -GCLH), GCLH));
                            acc[ai][bj][m][n][e] *= (1.0f + eb) * __builtin_amdgcn_rcpf(1.0f + ea); }
                asm volatile("" ::: "memory"); }
        }
    }
    __device__ __forceinline__ void operator()(Acc& acc, const Unit& u, int wr, int wc, int fr, int fq, const Pre& pre) const {
        int row0 = u.pm * BM + wr * 64 + fr; asm volatile("" : "+v"(row0)); const int col0 = u.pn * BM + wc * 32 + 8 * fq;
#pragma unroll
        for (int bj = 0; bj < 2; ++bj) {
            f32x4 bc[2]; u32x4 gc[8];
#pragma unroll
            for (int n = 0; n < 2; ++n) bc[n] = *(const f32x4*)(gb + 2 * DM + col0 + bj * HALF + 4 * n);
#pragma unroll
            for (int i = 0; i < 8; ++i) gc[i] = *(const u32x4*)(zg + (size_t)(row0 + (i >> 2) * HALF + (i & 3) * 16) * DIN + 2 * DM + col0 + bj * HALF);
            asm volatile("" : "+v"(gc[0]), "+v"(gc[1]), "+v"(gc[2]), "+v"(gc[3]), "+v"(gc[4]), "+v"(gc[5]), "+v"(gc[6]), "+v"(gc[7]));
#pragma unroll
            for (int i = 0; i < 8; ++i) { float o[8];
#pragma unroll
                for (int n = 0; n < 2; ++n)
#pragma unroll
                    for (int e = 0; e < 4; ++e) { const unsigned wcw = gc[i][n * 2 + (e >> 1)]; const float xc = ((e & 1) ? bf_hi(wcw) : bf_lo(wcw)) + bc[n][e];
                        o[n * 4 + e] = acc[i >> 2][bj][i & 3][n][e] * __builtin_amdgcn_rcpf(1.0f + fast_exp(-clampg(xc))); }
                u32x4 w; w.x = cvt_pk_bf16(o[0], o[1]); w.y = cvt_pk_bf16(o[2], o[3]); w.z = cvt_pk_bf16(o[4], o[5]); w.w = cvt_pk_bf16(o[6], o[7]);
                st_b128(O + (size_t)(row0 + (i >> 2) * HALF + (i & 3) * 16) * DM + col0 + bj * HALF, w); }
            asm volatile("" ::: "memory");
        }
    }
};

template <class Epi, int M, int N, int K>
__device__ __forceinline__ void gemm_phase(LAS unsigned char* lds, const bf16_t* gA, const bf16_t* gBt, int G_, int c_, const Epi& E) {
    int tid = threadIdx.x; asm volatile("" : "+v"(tid));
    const int wid = __builtin_amdgcn_readfirstlane(tid >> 6), lane = tid & 63, wr = wid >> 2, wc = wid & 3, fr = lane & 15, fq = lane >> 4;
    constexpr int nt = K / BK;
    StaticOrder<M, N> S; S.G = G_; S.c = c_;
    unsigned voffA[2], voffB[2];
#pragma unroll
    for (int i = 0; i < 2; ++i) { int R, C; stage_rc(tid * 16 + i * 8192, R, C); const int Rb = Epi::PERM ? ((R & ~31) + perm32(R & 31)) : R;
        voffA[i] = (unsigned)(R * K + C) * 2u; voffB[i] = (unsigned)(Rb * K + C) * 2u; }
    constexpr size_t kstep = (size_t)(BK * 2);
    constexpr size_t hstep = (size_t)HALF * K * 2;
    constexpr size_t tstep = 2 * hstep;
    const unsigned ldsw = (unsigned)wid * 1024u;
    const int aoff = lds_byte(wr * 64 + fr, fq * 8), boff = lds_byte(wc * 32 + fr, fq * 8);
#define PG8_SA(b, h) (((b) * 2 + (h)) * HTB)
#define PG8_SB(b, h) ((4 + (b) * 2 + (h)) * HTB)
    const unsigned ldsb = (unsigned)(uintptr_t)lds + ldsw;
#define PG8_STAGE(bufoff, gbase, voff) do { _Pragma("unroll") for (int _i = 0; _i < 2; ++_i) { \
        asm volatile("s_mov_b32 m0, %2\n\ts_nop 0\n\tglobal_load_lds_dwordx4 %0, %1" :: "v"((voff)[_i]), "s"((const char*)(gbase)), "s"(ldsb + (unsigned)((bufoff) + _i * 8192)) : "memory"); } } while (0)
#define PG8_LDA(dst, b, h) do { _Pragma("unroll") for (int m = 0; m < 4; ++m) _Pragma("unroll") for (int k = 0; k < 2; ++k) dst[m][k] = *(const LAS bf16x8*)(lds + PG8_SA(b, h) + aoff + m * 2048 + k * 1024); } while (0)
#define PG8_LDB(dst, b, h) do { _Pragma("unroll") for (int n = 0; n < 2; ++n) _Pragma("unroll") for (int k = 0; k < 2; ++k) dst[n][k] = *(const LAS bf16x8*)(lds + PG8_SB(b, h) + boff + n * 2048 + k * 1024); } while (0)
#define PG8_MMA(ai, bj, At, Bt) do { __builtin_amdgcn_s_setprio(1); _Pragma("unroll") for (int m = 0; m < 4; ++m) _Pragma("unroll") for (int n = 0; n < 2; ++n) _Pragma("unroll") for (int k = 0; k < 2; ++k) \
        acc[ai][bj][m][n] = __builtin_amdgcn_mfma_f32_16x16x32_bf16(Bt[n][k], At[m][k], acc[ai][bj][m][n], 0, 0, 0); __builtin_amdgcn_s_setprio(0); } while (0)
#define PG8_WAIT_V(n) asm volatile("s_waitcnt vmcnt(" #n ")" ::: "memory")
#define PG8_WAIT_L(n) asm volatile("s_waitcnt lgkmcnt(" #n ")" ::: "memory")
#define PG8_WAIT_V8R_(rel, N) asm volatile("s_waitcnt vmcnt(" #N ")\n\ts_cmp_lg_u32 %0, 0\n\ts_cbranch_scc1 1f\n\ts_waitcnt vmcnt(8)\n1:" :: "s"(rel) : "memory", "scc")
#define PG8_WAIT_V8R(rel) do { static_assert(Epi::TAIL == 8 || Epi::TAIL == 16 || Epi::TAIL == 24, "TAIL"); \
        if constexpr (Epi::TAIL == 8) PG8_WAIT_V8R_(rel, 16); else if constexpr (Epi::TAIL == 16) PG8_WAIT_V8R_(rel, 24); else PG8_WAIT_V8R_(rel, 32); } while (0)
#define PG8_BAR __builtin_amdgcn_s_barrier()
#define PG8_SCHED __builtin_amdgcn_sched_barrier(0)
    Unit cur, nxt; int ui = 0;
    if (!S.next(0, cur)) return;
    Acc acc;
#pragma unroll
    for (int a = 0; a < 2; ++a)
#pragma unroll
        for (int b = 0; b < 2; ++b)
#pragma unroll
            for (int m = 0; m < 4; ++m)
#pragma unroll
                for (int n = 0; n < 2; ++n) acc[a][b][m][n] = (f32x4){0.f, 0.f, 0.f, 0.f};
    bf16x8 At[4][2], B0[2][2], B1[2][2];
    const char* cA = (const char*)gA + (size_t)cur.pm * tstep; const char* cB = (const char*)gBt + (size_t)cur.pn * tstep;
    Pre pre;
    if constexpr (Epi::PRE) E.prefetch(pre, cur, wr, fr);
    PG8_STAGE(PG8_SB(0, 0), cB, voffB); PG8_STAGE(PG8_SB(0, 1), cB + hstep, voffB); PG8_STAGE(PG8_SA(0, 0), cA, voffA); PG8_STAGE(PG8_SA(0, 1), cA + hstep, voffA);
    if (wr == 1) PG8_BAR;
    PG8_WAIT_V(2); PG8_BAR;
    PG8_STAGE(PG8_SB(1, 0), cB + kstep, voffB); PG8_STAGE(PG8_SA(1, 0), cA + kstep, voffA); PG8_STAGE(PG8_SB(1, 1), cB + hstep + kstep, voffB);
    PG8_WAIT_V(6); PG8_BAR;
    __builtin_amdgcn_s_waitcnt(0x0F70);
    for (;;) {
        const bool has_next = S.next(ui + 1, nxt);
        const char* nA = has_next ? (const char*)gA + (size_t)nxt.pm * tstep : cA; const char* nB = has_next ? (const char*)gBt + (size_t)nxt.pn * tstep : cB;
        for (int t = 0; t < nt; t += 2) {
            if constexpr (Epi::HOOK) { if (t == 16 || t == 32) { PG8_SCHED; E.hook(acc, cur, t == 16 ? 0 : 1, wr, wc, fr, fq); PG8_WAIT_V(0); PG8_SCHED; } }
            const bool last = (t == nt - 2);
            const int rel = __builtin_amdgcn_readfirstlane((t == 0 && ui > 0 && RELAX) ? 1 : 0);
            const char* a1 = cA + (size_t)(t + 1) * kstep;
            const char* a2 = last ? nA : cA + (size_t)(t + 2) * kstep; const char* b2 = last ? nB : cB + (size_t)(t + 2) * kstep;
            const char* a3 = a2 + kstep; const char* b3 = b2 + kstep;
            PG8_LDB(B0, 0, 0); PG8_LDB(B1, 0, 1); PG8_SCHED; PG8_LDA(At, 0, 0); PG8_STAGE(PG8_SA(1, 1), a1 + hstep, voffA);
            PG8_WAIT_V8R(rel); PG8_WAIT_L(0); PG8_BAR; PG8_MMA(0, 0, At, B0); PG8_MMA(0, 1, At, B1); PG8_BAR; PG8_SCHED;
            PG8_LDA(At, 0, 1); PG8_STAGE(PG8_SB(0, 0), b2, voffB); PG8_STAGE(PG8_SB(0, 1), b2 + hstep, voffB); PG8_STAGE(PG8_SA(0, 0), a2, voffA);
            PG8_WAIT_V8R(rel); PG8_WAIT_L(0); PG8_BAR; PG8_MMA(1, 0, At, B0); PG8_MMA(1, 1, At, B1); PG8_BAR; PG8_SCHED;
            PG8_LDB(B0, 1, 0); PG8_LDB(B1, 1, 1); PG8_SCHED; PG8_LDA(At, 1, 0); PG8_STAGE(PG8_SA(0, 1), a2 + hstep, voffA);
            PG8_WAIT_V(8); PG8_WAIT_L(0); PG8_BAR; PG8_MMA(0, 0, At, B0); PG8_MMA(0, 1, At, B1); PG8_BAR; PG8_SCHED;
            PG8_LDA(At, 1, 1); PG8_STAGE(PG8_SB(1, 0), b3, voffB); PG8_STAGE(PG8_SB(1, 1), b3 + hstep, voffB); PG8_STAGE(PG8_SA(1, 0), a3, voffA);
            PG8_WAIT_V(8); PG8_WAIT_L(0); PG8_BAR; PG8_MMA(1, 0, At, B0); PG8_MMA(1, 1, At, B1); PG8_BAR; PG8_SCHED;
        }
        if (wr == 0) PG8_BAR;
        E(acc, cur, wr, wc, fr, fq, pre);
        if (!has_next) break;
        if constexpr (Epi::PRE) E.prefetch(pre, nxt, wr, fr);
#pragma unroll
        for (int a = 0; a < 2; ++a)
#pragma unroll
            for (int b = 0; b < 2; ++b)
#pragma unroll
                for (int m = 0; m < 4; ++m)
#pragma unroll
                    for (int n = 0; n < 2; ++n) acc[a][b][m][n] = (f32x4){0.f, 0.f, 0.f, 0.f};
        cur = nxt; cA = nA; cB = nB; ++ui;
        if (wr == 1) PG8_BAR;
    }
    PG8_WAIT_V(0);
    PG8_BAR;
#undef PG8_SA
#undef PG8_SB
#undef PG8_STAGE
#undef PG8_LDA
#undef PG8_LDB
#undef PG8_MMA
#undef PG8_WAIT_V
#undef PG8_WAIT_L
#undef PG8_WAIT_V8R
#undef PG8_WAIT_V8R_
#undef PG8_BAR
#undef PG8_SCHED
}
}

namespace att {
constexpr int D = 128, NW = 8, QBLK = 32, KVBLK = 64;
constexpr float SCALE = 0.088388347648318440f;
constexpr float THR = 8.f;
constexpr int LDQ = DIN, LDK = DIN, LDO = MIXW;
constexpr int SHM_V = KVBLK * D * 2, SHM_K = KVBLK * D * 2, SHM_ATTN = 2 * SHM_V + 2 * SHM_K + NW * 64 * 4;
#define KSWZ(row, colB) ((row) * 256 + ((colB) ^ (((row) & 7) << 4)))
#define SBAR() __builtin_amdgcn_sched_barrier(0)
__device__ __forceinline__ int crow(int r, int hi) { return (r & 3) + 8 * (r >> 2) + 4 * hi; }

__device__ __forceinline__ void partialSM(f32x16& p0, f32x16& p1, float& m_reg, float& mn, float& alpha) {
  constexpr float C = SCALE * 1.4426950408889634f;
  float pmax = p0[0];
#pragma unroll
  for (int r = 1; r < 16; ++r) pmax = fmaxf(pmax, p0[r]);
#pragma unroll
  for (int r = 0; r < 16; ++r) pmax = fmaxf(pmax, p1[r]);
  { auto rr = __builtin_amdgcn_permlane32_swap(__float_as_uint(pmax), __float_as_uint(pmax), false, false);
    pmax = fmaxf(__uint_as_float(rr[0]), __uint_as_float(rr[1])); }
  if (__builtin_expect(__all(pmax - m_reg <= THR / SCALE), 1)) { mn = m_reg; alpha = 1.f; }
  else { mn = fmaxf(m_reg, pmax); alpha = __builtin_amdgcn_exp2f((m_reg - mn) * C); m_reg = mn; }
  float mnC = -mn * C;
#pragma unroll
  for (int r = 0; r < 16; ++r) p0[r] = fmaf(p0[r], C, mnC);
#pragma unroll
  for (int r = 0; r < 16; ++r) p1[r] = fmaf(p1[r], C, mnC);
#pragma unroll
  for (int r = 0; r < 16; ++r) p0[r] = __builtin_amdgcn_exp2f(p0[r]);
}
__device__ __forceinline__ void finishSM(f32x16& p0, f32x16& p1, float alpha, float& l_reg, bf16x8& pa0, bf16x8& pa1, bf16x8& pa2, bf16x8& pa3) {
#pragma unroll
  for (int r = 0; r < 16; ++r) p1[r] = __builtin_amdgcn_exp2f(p1[r]);
  float ps = 0;
#pragma unroll
  for (int r = 0; r < 16; ++r) ps += p0[r];
#pragma unroll
  for (int r = 0; r < 16; ++r) ps += p1[r];
  { auto rr = __builtin_amdgcn_permlane32_swap(__float_as_uint(ps), __float_as_uint(ps), false, false);
    ps = __uint_as_float(rr[0]) + __uint_as_float(rr[1]); }
  l_reg = l_reg * alpha + ps;
#define PK8(P, BASE, OUT) do { u32x4 w = {cvt_pk_bf16(P[BASE + 0], P[BASE + 1]), cvt_pk_bf16(P[BASE + 2], P[BASE + 3]), cvt_pk_bf16(P[BASE + 4], P[BASE + 5]), cvt_pk_bf16(P[BASE + 6], P[BASE + 7])}; \
    OUT = *reinterpret_cast<bf16x8*>(&w); } while (0)
  PK8(p0, 0, pa0); PK8(p0, 8, pa1); PK8(p1, 0, pa2); PK8(p1, 8, pa3);
#undef PK8
}
__device__ __forceinline__ void qkt(f32x16& p0, f32x16& p1, const char* Ks, const bf16x8* qr, int r32, int hi) {
  p0 = f32x16{}; p1 = f32x16{};
#pragma unroll
  for (int d0 = 0; d0 < 8; ++d0) { int cb = (d0 * 16 + hi * 8) * 2;
    bf16x8 b0 = *reinterpret_cast<const bf16x8*>(Ks + KSWZ(r32, cb));
    bf16x8 b1 = *reinterpret_cast<const bf16x8*>(Ks + KSWZ(32 + r32, cb));
    p0 = __builtin_amdgcn_mfma_f32_32x32x16_bf16(b0, qr[d0], p0, 0, 0, 0);
    p1 = __builtin_amdgcn_mfma_f32_32x32x16_bf16(b1, qr[d0], p1, 0, 0, 0); }
}
__device__ __forceinline__ int v_st(int k, int c) { const int kk = (k & ~0xC) | ((k & 4) << 1) | ((k & 8) >> 1); return ((kk >> 3) * 4 + (c >> 5)) * 512 + ((kk & 7) * 32 + (c & 31)) * 2; }
__device__ __forceinline__ int v_rd_base(int lane) { return ((lane & 3) << 3) | (((lane >> 2) & 3) << 6) | (((lane >> 4) & 1) << 5) | (((lane >> 5) & 1) << 8); }
constexpr int v_rd_off(int d0, int ks, int half) { return d0 * 512 + ks * 4096 + half * 2048; }
template <int OFF> __device__ __forceinline__ s16x4 tr_read(int vb) {
  s16x4 r; asm volatile("ds_read_b64_tr_b16 %0, %1 offset:%2" : "=&v"(r) : "v"(vb), "i"(OFF) : "memory"); return r;
}
template <int D0> __device__ __forceinline__ void pv_one(f32x16& od, int vb, bf16x8 pa0, bf16x8 pa1, bf16x8 pa2, bf16x8 pa3) {
  const s16x4 l0 = tr_read<v_rd_off(D0, 0, 0)>(vb), h0 = tr_read<v_rd_off(D0, 0, 1)>(vb), l1 = tr_read<v_rd_off(D0, 1, 0)>(vb), h1 = tr_read<v_rd_off(D0, 1, 1)>(vb);
  const s16x4 l2 = tr_read<v_rd_off(D0, 2, 0)>(vb), h2 = tr_read<v_rd_off(D0, 2, 1)>(vb), l3 = tr_read<v_rd_off(D0, 3, 0)>(vb), h3 = tr_read<v_rd_off(D0, 3, 1)>(vb);
  asm volatile("s_waitcnt lgkmcnt(0)" ::: "memory"); SBAR();
#define PK(L, H) (bf16x8){L[0], L[1], L[2], L[3], H[0], H[1], H[2], H[3]}
  od = __builtin_amdgcn_mfma_f32_32x32x16_bf16(pa0, PK(l0, h0), od, 0, 0, 0);
  od = __builtin_amdgcn_mfma_f32_32x32x16_bf16(pa1, PK(l1, h1), od, 0, 0, 0);
  od = __builtin_amdgcn_mfma_f32_32x32x16_bf16(pa2, PK(l2, h2), od, 0, 0, 0);
  od = __builtin_amdgcn_mfma_f32_32x32x16_bf16(pa3, PK(l3, h3), od, 0, 0, 0);
#undef PK
}
struct VFrag { s16x4 l0, h0, l1, h1, l2, h2, l3, h3; };
template <int D0> __device__ __forceinline__ void v_rd8(VFrag& f, int vb) {
  f.l0 = tr_read<v_rd_off(D0, 0, 0)>(vb); f.h0 = tr_read<v_rd_off(D0, 0, 1)>(vb); f.l1 = tr_read<v_rd_off(D0, 1, 0)>(vb); f.h1 = tr_read<v_rd_off(D0, 1, 1)>(vb);
  f.l2 = tr_read<v_rd_off(D0, 2, 0)>(vb); f.h2 = tr_read<v_rd_off(D0, 2, 1)>(vb); f.l3 = tr_read<v_rd_off(D0, 3, 0)>(vb); f.h3 = tr_read<v_rd_off(D0, 3, 1)>(vb);
}
__device__ __forceinline__ void v_mma4(f32x16& od, const VFrag& f, bf16x8 pa0, bf16x8 pa1, bf16x8 pa2, bf16x8 pa3) {
#define PK(L, H) (bf16x8){L[0], L[1], L[2], L[3], H[0], H[1], H[2], H[3]}
  od = __builtin_amdgcn_mfma_f32_32x32x16_bf16(pa0, PK(f.l0, f.h0), od, 0, 0, 0);
  od = __builtin_amdgcn_mfma_f32_32x32x16_bf16(pa1, PK(f.l1, f.h1), od, 0, 0, 0);
  od = __builtin_amdgcn_mfma_f32_32x32x16_bf16(pa2, PK(f.l2, f.h2), od, 0, 0, 0);
  od = __builtin_amdgcn_mfma_f32_32x32x16_bf16(pa3, PK(f.l3, f.h3), od, 0, 0, 0);
#undef PK
}
__device__ __forceinline__ void pv_d0_pipe(f32x16* o, int vb, bf16x8 pa0, bf16x8 pa1, bf16x8 pa2, bf16x8 pa3) {
  VFrag fa, fb;
  SBAR(); v_rd8<0>(fa, vb); v_rd8<1>(fb, vb);
  asm volatile("s_waitcnt lgkmcnt(8)" ::: "memory"); SBAR(); v_mma4(o[0], fa, pa0, pa1, pa2, pa3); SBAR();
  v_rd8<2>(fa, vb);
  asm volatile("s_waitcnt lgkmcnt(8)" ::: "memory"); SBAR(); v_mma4(o[1], fb, pa0, pa1, pa2, pa3); SBAR();
  v_rd8<3>(fb, vb);
  asm volatile("s_waitcnt lgkmcnt(8)" ::: "memory"); SBAR(); v_mma4(o[2], fa, pa0, pa1, pa2, pa3); SBAR();
  asm volatile("s_waitcnt lgkmcnt(0)" ::: "memory"); SBAR(); v_mma4(o[3], fb, pa0, pa1, pa2, pa3);
}
__device__ __forceinline__ void pv_d0(f32x16* o, int vb, bf16x8 pa0, bf16x8 pa1, bf16x8 pa2, bf16x8 pa3) {
  pv_one<0>(o[0], vb, pa0, pa1, pa2, pa3); pv_one<1>(o[1], vb, pa0, pa1, pa2, pa3); pv_one<2>(o[2], vb, pa0, pa1, pa2, pa3); pv_one<3>(o[3], vb, pa0, pa1, pa2, pa3);
}

constexpr int RSLOT = 16384, LDS_KR = 0, LDS_VR = 3 * RSLOT, LDS_WS2 = 6 * RSLOT;
__device__ __forceinline__ void qkt_l(f32x16& p0, f32x16& p1, const LAS unsigned char* Ks, const bf16x8* qr, int r32, int hi) {
  p0 = f32x16{}; p1 = f32x16{};
#pragma unroll
  for (int d0 = 0; d0 < 8; ++d0) { int cb = (d0 * 16 + hi * 8) * 2;
    bf16x8 b0 = *reinterpret_cast<const LAS bf16x8*>(Ks + KSWZ(r32, cb));
    bf16x8 b1 = *reinterpret_cast<const LAS bf16x8*>(Ks + KSWZ(32 + r32, cb));
    p0 = __builtin_amdgcn_mfma_f32_32x32x16_bf16(b0, qr[d0], p0, 0, 0, 0);
    p1 = __builtin_amdgcn_mfma_f32_32x32x16_bf16(b1, qr[d0], p1, 0, 0, 0); }
}
__device__ __forceinline__ void attn_dense_body_dma(const bf16_t* __restrict__ Qb, const char* __restrict__ Kt, const char* __restrict__ Vt, bf16_t* __restrict__ Ob, int NT, LAS unsigned char* lds,
                                                    const float* __restrict__ qn, const f32x2* __restrict__ rope_row, const f32x2* __restrict__ rope_col, int pos0) {
  int tid = threadIdx.x; asm volatile("" : "+v"(tid));
  const int wid = __builtin_amdgcn_readfirstlane(tid >> 6), lane = tid & 63, r32 = lane & 31, hi = lane >> 5;
  LAS float* ws = (LAS float*)(lds + LDS_WS2) + wid * 64; LAS float* li_l = ws; LAS float* al_l = ws + 32;
  const unsigned dma_l = (unsigned)wid * 1024u;
  const unsigned dma_v = dma_l + (unsigned)lane * 16u;
  const unsigned ldsb = (unsigned)(uintptr_t)lds + dma_l;
#define DMA_PIECE(goff, gbase, ldst) do { asm volatile("s_mov_b32 m0, %2\n\ts_nop 0\n\tglobal_load_lds_dwordx4 %0, %1" :: "v"(goff), "s"(gbase), "s"(ldst) : "memory"); } while (0)
#define DMA_TILE(t, s) do { _Pragma("unroll") for (int _i = 0; _i < 2; ++_i) { \
    DMA_PIECE(dma_v + _i * 8192, Kt + (size_t)(t) * RSLOT, ldsb + (unsigned)(LDS_KR + (s) * RSLOT + _i * 8192)); \
    DMA_PIECE(dma_v + _i * 8192, Vt + (size_t)(t) * RSLOT, ldsb + (unsigned)(LDS_VR + (s) * RSLOT + _i * 8192)); } } while (0)
#define TILE_BAR() do { asm volatile("s_waitcnt vmcnt(0)" ::: "memory"); __builtin_amdgcn_s_barrier(); asm volatile("" ::: "memory"); } while (0)
  DMA_TILE(0, 0);
  float m_reg = -1e30f, l_reg = 0; f32x16 o[4] = {}; bf16x8 qr[8];
  const bf16_t* Qw = Qb + (long)(wid * QBLK + r32) * LDQ + hi * 8;
  {
    u32x4 raw[8];
#pragma unroll
    for (int d0 = 0; d0 < 8; ++d0) raw[d0] = *reinterpret_cast<const u32x4*>(Qw + d0 * 16);
    float y[8][8]; float ss = 0.f;
#pragma unroll
    for (int d0 = 0; d0 < 8; ++d0)
#pragma unroll
      for (int j = 0; j < 4; ++j) { y[d0][2 * j] = bf_lo(raw[d0][j]); y[d0][2 * j + 1] = bf_hi(raw[d0][j]); ss += y[d0][2 * j] * y[d0][2 * j] + y[d0][2 * j + 1] * y[d0][2 * j + 1]; }
    ss = xor32_sum(ss);
    const float rstd = 1.0f / sqrtf(ss * (1.0f / 128.0f) + EPS);
#pragma unroll
    for (int d0 = 0; d0 < 8; ++d0) { const f32x4 g0 = *(const f32x4*)(qn + d0 * 16 + hi * 8), g1 = *(const f32x4*)(qn + d0 * 16 + hi * 8 + 4);
#pragma unroll
      for (int j = 0; j < 4; ++j) { y[d0][j] *= rstd * g0[j]; y[d0][4 + j] *= rstd * g1[j]; } }
    const int pos = pos0 + wid * QBLK + r32;
#pragma unroll
    for (int blk = 0; blk < 2; ++blk) { const f32x2* tab = blk ? (rope_col + (pos & 63) * 32) : (rope_row + (pos >> 6) * 32);
#pragma unroll
      for (int dd = 0; dd < 2; ++dd) { const f32x4* tp = (const f32x4*)(tab + dd * 16 + hi * 8); const int da = 4 * blk + dd, db = da + 2;
#pragma unroll
        for (int j2 = 0; j2 < 4; ++j2) { const f32x4 cs = tp[j2];
          { const float x1 = y[da][2 * j2], x2 = y[db][2 * j2]; y[da][2 * j2] = x1 * cs[0] - x2 * cs[1]; y[db][2 * j2] = x2 * cs[0] + x1 * cs[1]; }
          { const float x1 = y[da][2 * j2 + 1], x2 = y[db][2 * j2 + 1]; y[da][2 * j2 + 1] = x1 * cs[2] - x2 * cs[3]; y[db][2 * j2 + 1] = x2 * cs[2] + x1 * cs[3]; } } } }
#pragma unroll
    for (int d0 = 0; d0 < 8; ++d0) { u32x4 w = {cvt_pk_bf16(y[d0][0], y[d0][1]), cvt_pk_bf16(y[d0][2], y[d0][3]), cvt_pk_bf16(y[d0][4], y[d0][5]), cvt_pk_bf16(y[d0][6], y[d0][7])};
      qr[d0] = *reinterpret_cast<bf16x8*>(&w); }
  }
  const int vrb = (int)(uintptr_t)(lds + LDS_VR) + v_rd_base(lane);
#define RESC(a) do { if (__any((a) < 1.f)) { if (hi == 0) al_l[r32] = (a); asm volatile("s_waitcnt lgkmcnt(0)" ::: "memory"); \
    _Pragma("unroll") for (int d = 0; d < 4; ++d) _Pragma("unroll") for (int r = 0; r < 16; ++r) o[d][r] *= al_l[crow(r, hi)]; } } while (0)
#define NEXT_SLOT(s) ((s) == 2 ? 0 : (s) + 1)
  f32x16 pA0, pA1, pB0, pB1; float mnA, mnB, alA, alB; bf16x8 pa0, pa1, pa2, pa3;
  TILE_BAR();
  DMA_TILE(1, 1);
  qkt_l(pA0, pA1, lds + LDS_KR, qr, r32, hi); partialSM(pA0, pA1, m_reg, mnA, alA);
  int sk = 1, sv = 0;
  for (int j = 1; j + 1 < NT; j += 2) {
    TILE_BAR(); { const int sn = NEXT_SLOT(sk); DMA_TILE(j + 1, sn); }
    SBAR(); qkt_l(pB0, pB1, lds + LDS_KR + sk * RSLOT, qr, r32, hi);
    finishSM(pA0, pA1, alA, l_reg, pa0, pa1, pa2, pa3); SBAR();
    pv_d0(o, vrb + sv * RSLOT, pa0, pa1, pa2, pa3); partialSM(pB0, pB1, m_reg, mnB, alB);
    RESC(alB);
    sv = sk; sk = NEXT_SLOT(sk);
    TILE_BAR(); if (j + 2 < NT) { const int sn = NEXT_SLOT(sk); DMA_TILE(j + 2, sn); }
    SBAR(); qkt_l(pA0, pA1, lds + LDS_KR + sk * RSLOT, qr, r32, hi);
    finishSM(pB0, pB1, alB, l_reg, pa0, pa1, pa2, pa3); SBAR();
    pv_d0(o, vrb + sv * RSLOT, pa0, pa1, pa2, pa3); partialSM(pA0, pA1, m_reg, mnA, alA);
    RESC(alA);
    sv = sk; sk = NEXT_SLOT(sk);
  }
  TILE_BAR();
  SBAR(); qkt_l(pB0, pB1, lds + LDS_KR + sk * RSLOT, qr, r32, hi);
  finishSM(pA0, pA1, alA, l_reg, pa0, pa1, pa2, pa3); SBAR();
  pv_d0(o, vrb + sv * RSLOT, pa0, pa1, pa2, pa3); partialSM(pB0, pB1, m_reg, mnB, alB);
  RESC(alB);
  finishSM(pB0, pB1, alB, l_reg, pa0, pa1, pa2, pa3); SBAR();
  pv_d0(o, vrb + sk * RSLOT, pa0, pa1, pa2, pa3);
  if (hi == 0) li_l[r32] = l_reg; asm volatile("s_waitcnt lgkmcnt(0)" ::: "memory");
  float rli[16];
#pragma unroll
  for (int r = 0; r < 16; ++r) rli[r] = __builtin_amdgcn_rcpf(li_l[crow(r, hi)]);
  bf16_t* Ow = Ob + (long)(wid * QBLK) * LDO;
#pragma unroll
  for (int r = 0; r < 16; ++r) { int orow = crow(r, hi);
#pragma unroll
    for (int d0 = 0; d0 < 4; ++d0) Ow[(long)orow * LDO + d0 * 32 + r32] = (bf16_t)(cvt_pk_bf16(o[d0][r] * rli[r], 0.f) & 0xffffu); }
#undef DMA_TILE
#undef DMA_PIECE
#undef TILE_BAR
#undef RESC
#undef NEXT_SLOT
}

__device__ __forceinline__ int krow(int kappa) { const int r = (kappa & 7) | ((kappa & 16) >> 1), hi = (kappa >> 3) & 1; return (r & 3) + 8 * (r >> 2) + 4 * hi; }
__device__ __forceinline__ void expA(f32x16& p0) {
#pragma unroll
  for (int r = 0; r < 16; ++r) p0[r] = __builtin_amdgcn_exp2f(p0[r]);
}
__device__ __forceinline__ void expB_pack(f32x16& p0, f32x16& p1, float& l_reg, bf16x8& pa0, bf16x8& pa1, bf16x8& pa2, bf16x8& pa3) {
#pragma unroll
  for (int r = 0; r < 16; ++r) p1[r] = __builtin_amdgcn_exp2f(p1[r]);
  float ps = 0;
#pragma unroll
  for (int r = 0; r < 16; ++r) ps += p0[r];
#pragma unroll
  for (int r = 0; r < 16; ++r) ps += p1[r];
  l_reg += ps;
#define PK8(P, BASE, OUT) do { u32x4 w = {cvt_pk_bf16(P[BASE + 0], P[BASE + 1]), cvt_pk_bf16(P[BASE + 2], P[BASE + 3]), cvt_pk_bf16(P[BASE + 4], P[BASE + 5]), cvt_pk_bf16(P[BASE + 6], P[BASE + 7])}; \
    OUT = *reinterpret_cast<bf16x8*>(&w); } while (0)
  PK8(p0, 0, pa0); PK8(p0, 8, pa1); PK8(p1, 0, pa2); PK8(p1, 8, pa3);
#undef PK8
}
__device__ __forceinline__ void attn_body_maxfree(const bf16_t* __restrict__ Qb, const char* __restrict__ Kt, const char* __restrict__ Vt, bf16_t* __restrict__ Ob, int NT, LAS unsigned char* lds,
                                                  const float* __restrict__ qn, const f32x2* __restrict__ rope_row, const f32x2* __restrict__ rope_col, int pos0) {
  int tid = threadIdx.x; asm volatile("" : "+v"(tid));
  const int wid = __builtin_amdgcn_readfirstlane(tid >> 6), lane = tid & 63, r32 = lane & 31, hi = lane >> 5;
  LAS float* li_l = (LAS float*)(lds + LDS_WS2) + wid * 64;
  const unsigned dma_l = (unsigned)wid * 1024u;
  const unsigned dma_v = dma_l + (unsigned)lane * 16u;
  const unsigned ldsb = (unsigned)(uintptr_t)lds + dma_l;
#define DMA_PIECE(goff, gbase, ldst) do { asm volatile("s_mov_b32 m0, %2\n\ts_nop 0\n\tglobal_load_lds_dwordx4 %0, %1" :: "v"(goff), "s"(gbase), "s"(ldst) : "memory"); } while (0)
#define DMA_TILE(t, s) do { _Pragma("unroll") for (int _i = 0; _i < 2; ++_i) { \
    DMA_PIECE(dma_v + _i * 8192, Kt + (size_t)(t) * RSLOT, ldsb + (unsigned)(LDS_KR + (s) * RSLOT + _i * 8192)); \
    DMA_PIECE(dma_v + _i * 8192, Vt + (size_t)(t) * RSLOT, ldsb + (unsigned)(LDS_VR + (s) * RSLOT + _i * 8192)); } } while (0)
#define TILE_BAR() do { asm volatile("s_waitcnt vmcnt(0)" ::: "memory"); __builtin_amdgcn_s_barrier(); asm volatile("" ::: "memory"); } while (0)
  DMA_TILE(0, 0);
  float l_reg = 0; f32x16 o[4] = {}; bf16x8 qr[8];
  const bf16_t* Qw = Qb + (long)(wid * QBLK + r32) * LDQ + hi * 8;
  {
    u32x4 raw[8];
#pragma unroll
    for (int d0 = 0; d0 < 8; ++d0) raw[d0] = *reinterpret_cast<const u32x4*>(Qw + d0 * 16);
    float y[8][8]; float ss = 0.f;
#pragma unroll
    for (int d0 = 0; d0 < 8; ++d0)
#pragma unroll
      for (int j = 0; j < 4; ++j) { y[d0][2 * j] = bf_lo(raw[d0][j]); y[d0][2 * j + 1] = bf_hi(raw[d0][j]); ss += y[d0][2 * j] * y[d0][2 * j] + y[d0][2 * j + 1] * y[d0][2 * j + 1]; }
    ss = xor32_sum(ss);
    const float rstd = (SCALE * 1.4426950408889634f) / sqrtf(ss * (1.0f / 128.0f) + EPS);
#pragma unroll
    for (int d0 = 0; d0 < 8; ++d0) { const f32x4 g0 = *(const f32x4*)(qn + d0 * 16 + hi * 8), g1 = *(const f32x4*)(qn + d0 * 16 + hi * 8 + 4);
#pragma unroll
      for (int j = 0; j < 4; ++j) { y[d0][j] *= rstd * g0[j]; y[d0][4 + j] *= rstd * g1[j]; } }
    const int pos = pos0 + wid * QBLK + r32;
#pragma unroll
    for (int blk = 0; blk < 2; ++blk) { const f32x2* tab = blk ? (rope_col + (pos & 63) * 32) : (rope_row + (pos >> 6) * 32);
#pragma unroll
      for (int dd = 0; dd < 2; ++dd) { const f32x4* tp = (const f32x4*)(tab + dd * 16 + hi * 8); const int da = 4 * blk + dd, db = da + 2;
#pragma unroll
        for (int j2 = 0; j2 < 4; ++j2) { const f32x4 cs = tp[j2];
          { const float x1 = y[da][2 * j2], x2 = y[db][2 * j2]; y[da][2 * j2] = x1 * cs[0] - x2 * cs[1]; y[db][2 * j2] = x2 * cs[0] + x1 * cs[1]; }
          { const float x1 = y[da][2 * j2 + 1], x2 = y[db][2 * j2 + 1]; y[da][2 * j2 + 1] = x1 * cs[2] - x2 * cs[3]; y[db][2 * j2 + 1] = x2 * cs[2] + x1 * cs[3]; } } } }
#pragma unroll
    for (int d0 = 0; d0 < 8; ++d0) { u32x4 w = {cvt_pk_bf16(y[d0][0], y[d0][1]), cvt_pk_bf16(y[d0][2], y[d0][3]), cvt_pk_bf16(y[d0][4], y[d0][5]), cvt_pk_bf16(y[d0][6], y[d0][7])};
      qr[d0] = *reinterpret_cast<bf16x8*>(&w); }
  }
  const int vrb = (int)(uintptr_t)(lds + LDS_VR) + v_rd_base(lane);
#define NEXT_SLOT(s) ((s) == 2 ? 0 : (s) + 1)
  f32x16 pA0, pA1, pB0, pB1; bf16x8 pa0, pa1, pa2, pa3;
  if (wid >= 4) __builtin_amdgcn_s_setprio(1);
  TILE_BAR();
  DMA_TILE(1, 1);
  qkt_l(pA0, pA1, lds + LDS_KR, qr, r32, hi); expA(pA0);
  int sk = 1, sv = 0;
  for (int j = 1; j + 1 < NT; j += 2) {
    TILE_BAR(); { const int sn = NEXT_SLOT(sk); DMA_TILE(j + 1, sn); }
    SBAR(); qkt_l(pB0, pB1, lds + LDS_KR + sk * RSLOT, qr, r32, hi);
    expB_pack(pA0, pA1, l_reg, pa0, pa1, pa2, pa3); SBAR();
    pv_d0_pipe(o, vrb + sv * RSLOT, pa0, pa1, pa2, pa3); expA(pB0);
    sv = sk; sk = NEXT_SLOT(sk);
    TILE_BAR(); if (j + 2 < NT) { const int sn = NEXT_SLOT(sk); DMA_TILE(j + 2, sn); }
    SBAR(); qkt_l(pA0, pA1, lds + LDS_KR + sk * RSLOT, qr, r32, hi);
    expB_pack(pB0, pB1, l_reg, pa0, pa1, pa2, pa3); SBAR();
    pv_d0_pipe(o, vrb + sv * RSLOT, pa0, pa1, pa2, pa3); expA(pA0);
    sv = sk; sk = NEXT_SLOT(sk);
  }
  TILE_BAR();
  SBAR(); qkt_l(pB0, pB1, lds + LDS_KR + sk * RSLOT, qr, r32, hi);
  expB_pack(pA0, pA1, l_reg, pa0, pa1, pa2, pa3); SBAR();
  pv_d0_pipe(o, vrb + sv * RSLOT, pa0, pa1, pa2, pa3); expA(pB0);
  expB_pack(pB0, pB1, l_reg, pa0, pa1, pa2, pa3); SBAR();
  pv_d0_pipe(o, vrb + sk * RSLOT, pa0, pa1, pa2, pa3);
  __builtin_amdgcn_s_setprio(0);
  l_reg = xor32_sum(l_reg);
  if (hi == 0) li_l[r32] = l_reg; asm volatile("s_waitcnt lgkmcnt(0)" ::: "memory");
  float rli[16];
#pragma unroll
  for (int r = 0; r < 16; ++r) rli[r] = __builtin_amdgcn_rcpf(li_l[crow(r, hi)]);
  bf16_t* Ow = Ob + (long)(wid * QBLK) * LDO;
#pragma unroll
  for (int r = 0; r < 16; ++r) { int orow = crow(r, hi);
#pragma unroll
    for (int d0 = 0; d0 < 4; ++d0) Ow[(long)orow * LDO + d0 * 32 + r32] = (bf16_t)(cvt_pk_bf16(o[d0][r] * rli[r], 0.f) & 0xffffu); }
#undef DMA_TILE
#undef DMA_PIECE
#undef TILE_BAR
#undef NEXT_SLOT
}
}

struct Args {
    const float* x_prompt; const float* x_sample; const float* norm_mix; const float* w_in; const float* gate_bias; const float* conv_w; const float* sgu_ln; const float* sgu_ws;
    const float* sgu_b; const float* q_norm; const float* k_norm; const float* w_br_conv; const float* w_br_sgu; const float* w_br_attn; const float* w_out; const float* norm_ffn;
    const float* w_ffn_in; const float* w_ffn_out; const float* norm_final; float* out; unsigned char* ws;
};
#define GASQ __attribute__((address_space(1)))
struct ArgsD {
    const GASQ float* x_prompt; const GASQ float* x_sample; const GASQ float* norm_mix; const GASQ float* w_in; const GASQ float* gate_bias; const GASQ float* conv_w; const GASQ float* sgu_ln; const GASQ float* sgu_ws;
    const GASQ float* sgu_b; const GASQ float* q_norm; const GASQ float* k_norm; const GASQ float* w_br_conv; const GASQ float* w_br_sgu; const GASQ float* w_br_attn; const GASQ float* w_out; const GASQ float* norm_ffn;
    const GASQ float* w_ffn_in; const GASQ float* w_ffn_out; const GASQ float* norm_final; GASQ float* out; GASQ unsigned char* ws;
};
static_assert(sizeof(ArgsD) == sizeof(Args), "ArgsD mirrors Args");
#define ARG(f) ((decltype(Args::f))(a->f))
typedef const __attribute__((address_space(4))) ArgsD* KArgs;
__device__ __forceinline__ KArgs kargs() { KArgs p = (KArgs)__builtin_amdgcn_kernarg_segment_ptr(); asm volatile("" : "+s"(p)); return p; }
__device__ __forceinline__ int opaque_tid() { int t = threadIdx.x; asm volatile("" : "+v"(t)); return t; }

__device__ __forceinline__ void transpose_item(const float* W, int ldw, int scol0, int k0, bf16_t* dst, int ldk, LAS float* scr, int lane, const float* gain) {
#pragma unroll 8
    for (int i = 0; i < 32; ++i) { const int kk = 2 * i + (lane >> 5); const float gk = gain ? gain[k0 + kk] : 1.0f; scr[kk * 33 + (lane & 31)] = W[(size_t)(k0 + kk) * ldw + scol0 + (lane & 31)] * gk; }
    LDS_WAIT(); asm volatile("" ::: "memory");
    const int c = lane & 7;
#pragma unroll
    for (int j = 0; j < 4; ++j) { const int n = (lane >> 3) + 8 * j; const LAS float* s = scr + (8 * c) * 33 + n;
        u32x4 o; o.x = cvt_pk_bf16(s[0 * 33], s[1 * 33]); o.y = cvt_pk_bf16(s[2 * 33], s[3 * 33]); o.z = cvt_pk_bf16(s[4 * 33], s[5 * 33]); o.w = cvt_pk_bf16(s[6 * 33], s[7 * 33]);
        *(u32x4*)(dst + (size_t)n * ldk + 8 * c) = o; }
    LDS_WAIT(); asm volatile("" ::: "memory");
}

__device__ __forceinline__ void sincos_d(double a, double& s, double& c) {
    const double k = __builtin_rint(a * 0.63661977236758134308);
    double r = a - k * 1.57079632673412561417e+00; r = r - k * 6.07710050650619224932e-11;
    const double r2 = r * r;
    double sp = -1.0 / 1307674368000.0; sp = sp * r2 + 1.0 / 6227020800.0; sp = sp * r2 - 1.0 / 39916800.0; sp = sp * r2 + 1.0 / 362880.0; sp = sp * r2 - 1.0 / 5040.0; sp = sp * r2 + 1.0 / 120.0; sp = sp * r2 - 1.0 / 6.0; sp = sp * r2 + 1.0;
    const double sn = r * sp;
    double cp = 1.0 / 20922789888000.0; cp = cp * r2 - 1.0 / 87178291200.0; cp = cp * r2 + 1.0 / 479001600.0; cp = cp * r2 - 1.0 / 3628800.0; cp = cp * r2 + 1.0 / 40320.0; cp = cp * r2 - 1.0 / 720.0; cp = cp * r2 + 1.0 / 24.0; cp = cp * r2 - 0.5; cp = cp * r2 + 1.0;
    const int q = ((int)k) & 3;
    s = (q == 0) ? sn : (q == 1) ? cp : (q == 2) ? -sn : -cp;
    c = (q == 0) ? cp : (q == 1) ? -sn : (q == 2) ? -cp : sn;
}

__device__ __forceinline__ void phase_prologue(LAS unsigned char* lds) {
    KArgs a = kargs(); const int tid = opaque_tid(), lane = tid & 63, wave = __builtin_amdgcn_readfirstlane(tid >> 6);
    const int G = gridDim.x, bx = blockIdx.x, gw = bx * 8 + wave, NGW = G * 8;
    unsigned char* ws = ARG(ws);
    bf16_t* Win_t = (bf16_t*)(ws + WS_WIN); bf16_t* Wbr_t = (bf16_t*)(ws + WS_WBR); bf16_t* Wout_t = (bf16_t*)(ws + WS_WOUT); bf16_t* Wfi_t = (bf16_t*)(ws + WS_WFI); bf16_t* Wfo_t = (bf16_t*)(ws + WS_WFO);
    LAS float* scr = (LAS float*)(lds + wave * 9216);
    constexpr int I_IN = 32 * 448, I_BC = 16 * 64, I_BA = 32 * 64, I_O = 32 * 64, I_FI = 32 * 352, I_FO = 88 * 64;
    constexpr int PER_LAYER = I_IN + 2 * I_BC + I_BA + I_O + I_FI + I_FO, TOTAL = DEPTH * PER_LAYER;
    struct TItem { const float* src; bf16_t* dst; const float* gain; int ldw, ldk; };
    auto titem = [&](int it) -> TItem {
        const int layer = it / PER_LAYER; int r = it - layer * PER_LAYER; TItem t;
        if (r < I_IN) { const int kb = r / 448, nb = r % 448, k0 = 64 * kb, n0 = 32 * nb;
            t.src = ARG(w_in) + (size_t)layer * DM * DIN + (size_t)k0 * DIN + n0; t.ldw = DIN; t.dst = Win_t + (size_t)layer * DIN * DM + (size_t)n0 * DM + k0; t.ldk = DM; t.gain = ARG(norm_mix) + layer * DM + k0; return t; }
        r -= I_IN;
        if (r < I_BC) { const int kb = r / 64, nb = r % 64, k0 = 64 * kb, n0 = 32 * nb;
            t.src = ARG(w_br_conv) + (size_t)layer * 1024 * DM + (size_t)k0 * DM + n0; t.ldw = DM; t.dst = Wbr_t + (size_t)layer * DM * MIXW + (size_t)n0 * MIXW + k0; t.ldk = MIXW; t.gain = nullptr; return t; }
        r -= I_BC;
        if (r < I_BC) { const int kb = r / 64, nb = r % 64, k0 = 64 * kb, n0 = 32 * nb;
            t.src = ARG(w_br_sgu) + (size_t)layer * 1024 * DM + (size_t)k0 * DM + n0; t.ldw = DM; t.dst = Wbr_t + (size_t)layer * DM * MIXW + (size_t)n0 * MIXW + 1024 + k0; t.ldk = MIXW; t.gain = nullptr; return t; }
        r -= I_BC;
        if (r < I_BA) { const int kb = r / 64, nb = r % 64, k0 = 64 * kb, n0 = 32 * nb;
            t.src = ARG(w_br_attn) + (size_t)layer * DM * DM + (size_t)k0 * DM + n0; t.ldw = DM; t.dst = Wbr_t + (size_t)layer * DM * MIXW + (size_t)n0 * MIXW + 2048 + k0; t.ldk = MIXW; t.gain = nullptr; return t; }
        r -= I_BA;
        if (r < I_O) { const int kb = r / 64, nb = r % 64, k0 = 64 * kb, n0 = 32 * nb;
            t.src = ARG(w_out) + (size_t)layer * DM * DM + (size_t)k0 * DM + n0; t.ldw = DM; t.dst = Wout_t + (size_t)layer * DM * DM + (size_t)n0 * DM + k0; t.ldk = DM; t.gain = nullptr; return t; }
        r -= I_O;
        if (r < I_FI) { const int kb = r / 352, nb = r % 352, k0 = 64 * kb, n0 = 32 * nb, tile = n0 >> 8, w = n0 & 255;
            const int scol0 = (w < 128) ? (128 * tile + w) : (DFF + 128 * tile + (w - 128));
            t.src = ARG(w_ffn_in) + (size_t)layer * DM * NFF2 + (size_t)k0 * NFF2 + scol0; t.ldw = NFF2; t.dst = Wfi_t + (size_t)layer * NFF2 * DM + (size_t)n0 * DM + k0; t.ldk = DM; t.gain = ARG(norm_ffn) + layer * DM + k0; return t; }
        r -= I_FI;
        { const int kb = r / 64, nb = r % 64, k0 = 64 * kb, n0 = 32 * nb;
            t.src = ARG(w_ffn_out) + (size_t)layer * DFF * DM + (size_t)k0 * DM + n0; t.ldw = DM; t.dst = Wfo_t + (size_t)layer * DM * DFF + (size_t)n0 * DFF + k0; t.ldk = DFF; t.gain = nullptr; return t; }
    };
    const float* ones_or_any = ARG(norm_final);
    const int lr = lane >> 3, lc = (lane & 7) * 4;
    if (gw < TOTAL) {
        TItem cur = titem(gw); f32x4 v[8]; float gv[8];
#pragma unroll
        for (int i = 0; i < 8; ++i) { v[i] = *(const f32x4*)(cur.src + (size_t)(8 * i + lr) * cur.ldw + lc); gv[i] = (cur.gain ? cur.gain : ones_or_any)[8 * i + lr]; }
        for (int it = gw; it < TOTAL; it += NGW) {
            const int nit = (it + NGW < TOTAL) ? it + NGW : it;
            const TItem nx = titem(nit); f32x4 nv[8]; float ng[8];
#pragma unroll
            for (int i = 0; i < 8; ++i) { nv[i] = *(const f32x4*)(nx.src + (size_t)(8 * i + lr) * nx.ldw + lc); ng[i] = (nx.gain ? nx.gain : ones_or_any)[8 * i + lr]; }
            const bool hg = cur.gain != nullptr;
#pragma unroll
            for (int i = 0; i < 8; ++i) { const float g = hg ? gv[i] : 1.0f; *(LAS f32x4*)(scr + (8 * i + lr) * 36 + lc) = v[i] * g; }
            LDS_WAIT(); asm volatile("" ::: "memory");
            { const int n = lane & 31, g2 = lane >> 5;
#pragma unroll
              for (int j = 0; j < 4; ++j) { const int c = g2 + 2 * j; const LAS float* sp = scr + (8 * c) * 36 + n;
                  u32x4 o; o.x = cvt_pk_bf16(sp[0 * 36], sp[1 * 36]); o.y = cvt_pk_bf16(sp[2 * 36], sp[3 * 36]); o.z = cvt_pk_bf16(sp[4 * 36], sp[5 * 36]); o.w = cvt_pk_bf16(sp[6 * 36], sp[7 * 36]);
                  *(u32x4*)(cur.dst + (size_t)n * cur.ldk + 8 * c) = o; } }
            LDS_WAIT(); asm volatile("" ::: "memory");
            cur = nx;
#pragma unroll
            for (int i = 0; i < 8; ++i) { v[i] = nv[i]; gv[i] = ng[i]; }
        }
    }
    const int gt = bx * 512 + tid, NT = G * 512;
    unsigned* SGUWb = (unsigned*)(ws + WS_SGUW); const f32x2* sw = (const f32x2*)ARG(sgu_ws);
    for (int i = gt; i < DEPTH * 8 * 128 * 128 / 2; i += NT) { const f32x2 v = sw[i]; SGUWb[i] = cvt_pk_bf16(v.x, v.y); }
    { bf16_t* XBA = (bf16_t*)(ws + WS_XBA); unsigned* SS = (unsigned*)(ws + WS_SS);
      for (int m = gw; m < NTOK; m += NGW) { const float* xrow = (m < 2 * TG) ? ARG(x_prompt) + (size_t)m * DM : ARG(x_sample) + (size_t)(m - 2 * TG) * DM;
          const f32x4* xr = (const f32x4*)xrow + lane; f32x4 v[8]; float sq = 0.f;
#pragma unroll
          for (int j = 0; j < 8; ++j) { v[j] = xr[64 * j]; sq += (v[j].x * v[j].x + v[j].y * v[j].y) + (v[j].z * v[j].z + v[j].w * v[j].w); }
          sq = wave_sum(sq);
          u32x2* o8 = (u32x2*)(XBA + (size_t)m * DM) + lane;
#pragma unroll
          for (int j = 0; j < 8; ++j) { u32x2 w; w.x = cvt_pk_bf16(v[j].x, v[j].y); w.y = cvt_pk_bf16(v[j].z, v[j].w); o8[64 * j] = w; }
          if (lane == 0) SS[m] = (unsigned)(sq * SS_SCALE + 0.5f); } }
    f32x2* rope = (f32x2*)(ws + WS_ROPE);
    for (int i = gt; i < 192 * 32; i += NT) { const int pos = i >> 5, f = i & 31;
        double inv = 1.0; for (int j = 0; j < f; ++j) inv *= 0.7498942093324559;
        const double ang = (double)(pos < 128 ? pos : pos - 128) * inv; double s, c; sincos_d(ang, s, c);
        rope[i] = (f32x2){(float)c, (float)s}; }
}

__device__ __forceinline__ void phase_sgu(int layer, LAS unsigned char* lds) {
    KArgs a = kargs(); const int tid = opaque_tid(), lane = tid & 63, wave = __builtin_amdgcn_readfirstlane(tid >> 6);
    unsigned char* ws = ARG(ws); bf16_t* Zb = (bf16_t*)(ws + WS_Z); bf16_t* MIXb = (bf16_t*)(ws + WS_MIX); const bf16_t* SGUWb = (const bf16_t*)(ws + WS_SGUW);
    const float* sgu_ln = ARG(sgu_ln) + layer * 1024; const float* sgu_b = ARG(sgu_b) + layer * 1024;
    LAS float* ot = (LAS float*)(lds + 32768); LAS f32x2* stat = (LAS f32x2*)(lds + 102400);
    for (int item = blockIdx.x; item < 256; item += gridDim.x) {
        const int chunk = item >> 1, half = item & 1, R0 = chunk * 128;
#pragma unroll
        for (int bt = 0; bt < 2; ++bt) { u32x4 w0[8], w1[8];
#pragma unroll
            for (int i = 0; i < 8; ++i) { const bf16_t* p = Zb + (size_t)(R0 + wave * 16 + bt * 8 + i) * DIN + ZC_SV + lane * 16; w0[i] = *(const u32x4*)p; w1[i] = *(const u32x4*)(p + 8); }
            float s[8];
#pragma unroll
            for (int i = 0; i < 8; ++i) { float ac = 0.f;
#pragma unroll
                for (int j = 0; j < 4; ++j) ac += (bf_lo(w0[i][j]) + bf_hi(w0[i][j])) + (bf_lo(w1[i][j]) + bf_hi(w1[i][j]));
                s[i] = ac; }
#pragma unroll
            for (int i = 0; i < 8; ++i) s[i] = wave_sum(s[i]) * (1.0f / 1024.0f);
            float q[8];
#pragma unroll
            for (int i = 0; i < 8; ++i) { float ac = 0.f;
#pragma unroll
                for (int j = 0; j < 4; ++j) { const float d0 = bf_lo(w0[i][j]) - s[i], d1 = bf_hi(w0[i][j]) - s[i], d2 = bf_lo(w1[i][j]) - s[i], d3 = bf_hi(w1[i][j]) - s[i]; ac += (d0 * d0 + d1 * d1) + (d2 * d2 + d3 * d3); }
                q[i] = ac; }
#pragma unroll
            for (int i = 0; i < 8; ++i) q[i] = wave_sum(q[i]);
#pragma unroll
            for (int i = 0; i < 8; ++i) if (lane == i) stat[wave * 16 + bt * 8 + i] = (f32x2){s[i], 1.0f / sqrtf(q[i] * (1.0f / 1024.0f) + EPS)}; }
        LDS_WAIT(); __syncthreads();
        const int r32 = lane & 31, hi = lane >> 5, pb = wave & 3, dd = wave >> 2;
        for (int gi = 0; gi < 4; ++gi) { const int g = half * 4 + gi;
            u32x4 wv[4], wu[4];
#pragma unroll
            for (int i = 0; i < 4; ++i) { const int pid = tid + 512 * i, q = pid >> 4, c8 = (pid & 15) * 8; const bf16_t* zr = Zb + (size_t)(R0 + q) * DIN + g * 128 + c8;
                wv[i] = *(const u32x4*)(zr + ZC_SV); wu[i] = *(const u32x4*)(zr + ZC_SU); }
            const bf16_t* Wg = SGUWb + ((size_t)(layer * 8 + g) * 128 + 32 * pb + r32) * 128 + hi * 8;
            bf16x8 pa[2][4];
#pragma unroll
            for (int tl = 0; tl < 2; ++tl)
#pragma unroll
                for (int ks = 0; ks < 4; ++ks) pa[tl][ks] = *(const bf16x8*)(Wg + tl * 64 + ks * 16);
#pragma unroll
            for (int i = 0; i < 4; ++i) { const int pid = tid + 512 * i, q = pid >> 4, c8 = (pid & 15) * 8; const u32x4 w = wv[i]; const f32x2 st = stat[q];
                const f32x4 g0 = *(const f32x4*)(sgu_ln + g * 128 + c8), g1 = *(const f32x4*)(sgu_ln + g * 128 + c8 + 4);
                u32x4 o; o.x = cvt_pk_bf16((bf_lo(w.x) - st.x) * st.y * g0.x, (bf_hi(w.x) - st.x) * st.y * g0.y); o.y = cvt_pk_bf16((bf_lo(w.y) - st.x) * st.y * g0.z, (bf_hi(w.y) - st.x) * st.y * g0.w);
                o.z = cvt_pk_bf16((bf_lo(w.z) - st.x) * st.y * g1.x, (bf_hi(w.z) - st.x) * st.y * g1.y); o.w = cvt_pk_bf16((bf_lo(w.w) - st.x) * st.y * g1.z, (bf_hi(w.w) - st.x) * st.y * g1.w);
                *(LAS u32x4*)(lds + (q >> 6) * 16384 + att::v_st(q & 63, c8)) = o; }
            LDS_WAIT(); __syncthreads();
            f32x16 o0 = {}, o1 = {};
#pragma unroll
            for (int tl = 0; tl < 2; ++tl) { const int vb = (int)(uintptr_t)(lds + tl * 16384) + att::v_rd_base(lane) + dd * 1024;
                att::pv_one<0>(o0, vb, pa[tl][0], pa[tl][1], pa[tl][2], pa[tl][3]); att::pv_one<1>(o1, vb, pa[tl][0], pa[tl][1], pa[tl][2], pa[tl][3]); }
            const float* bs = sgu_b + g * 128 + 32 * pb;
#pragma unroll
            for (int r = 0; r < 16; ++r) { const int p = att::crow(r, hi); const float bias = bs[p]; LAS float* orow = ot + (32 * pb + p) * 132 + 64 * dd + r32;
                orow[0] = o0[r] + bias; orow[32] = o1[r] + bias; }
            LDS_WAIT(); __syncthreads();
#pragma unroll
            for (int i = 0; i < 4; ++i) { const int pid = tid + 512 * i, q = pid >> 4, c8 = (pid & 15) * 8; const u32x4 u = wu[i];
                const f32x4 m0 = *(const LAS f32x4*)(ot + q * 132 + c8), m1 = *(const LAS f32x4*)(ot + q * 132 + c8 + 4);
                u32x4 o; o.x = cvt_pk_bf16(bf_lo(u.x) * m0[0], bf_hi(u.x) * m0[1]); o.y = cvt_pk_bf16(bf_lo(u.y) * m0[2], bf_hi(u.y) * m0[3]);
                o.z = cvt_pk_bf16(bf_lo(u.z) * m1[0], bf_hi(u.z) * m1[1]); o.w = cvt_pk_bf16(bf_lo(u.w) * m1[2], bf_hi(u.w) * m1[3]);
                *(u32x4*)(MIXb + (size_t)(R0 + q) * MIXW + 1024 + g * 128 + c8) = o; }
            LDS_WAIT(); __syncthreads(); }
    }
}

__device__ __forceinline__ void phase_conv_k(int layer, int grp) {
    KArgs a = kargs(); const int tid = opaque_tid(), lane = tid & 63, wave = __builtin_amdgcn_readfirstlane(tid >> 6);
    const int gw = blockIdx.x * 8 + wave, NGW = gridDim.x * 8;
    unsigned char* ws = ARG(ws); bf16_t* Zb = (bf16_t*)(ws + WS_Z); bf16_t* MIXb = (bf16_t*)(ws + WS_MIX);
    const f32x2* rope_row = (const f32x2*)(ws + WS_ROPE); const f32x2* rope_col = rope_row + 128 * 32; char* KT = (char*)(ws + WS_KT); char* VT = (char*)(ws + WS_VT);
    const float* conv_w = ARG(conv_w) + (size_t)layer * 3 * 1024; const float* k_norm = ARG(k_norm) + layer * 128;
    { unsigned* SS = (unsigned*)(ws + WS_SS);
      for (int i = blockIdx.x * 512 + tid; i < TG; i += gridDim.x * 512) __hip_atomic_store(SS + (size_t)grp * TG + i, 0u, __ATOMIC_RELAXED, __HIP_MEMORY_SCOPE_AGENT); }
    for (int item = gw; item < (TG / 4) * 2; item += NGW) { const int blk = item >> 1, hf = item & 1, t0 = blk * 4, s0 = t0 & (SEQ - 1), c0 = hf * 512 + lane * 8;
        u32x4 cc[6], cx[6], cb[4];
#pragma unroll
        for (int i = 0; i < 6; ++i) { int row = t0 - 1 + i; row = (i == 0 && s0 == 0) ? t0 : row; row = (i == 5 && s0 == SEQ - 4) ? t0 + 3 : row;
            cc[i] = *(const u32x4*)(Zb + (size_t)row * DIN + ZC_CC + c0); cx[i] = *(const u32x4*)(Zb + (size_t)row * DIN + ZC_CX + c0); }
#pragma unroll
        for (int i = 0; i < 4; ++i) cb[i] = *(const u32x4*)(Zb + (size_t)(t0 + i) * DIN + ZC_CB + c0);
        const f32x4 wa0 = *(const f32x4*)(conv_w + c0), wa1 = *(const f32x4*)(conv_w + c0 + 4), wb0 = *(const f32x4*)(conv_w + 1024 + c0), wb1 = *(const f32x4*)(conv_w + 1024 + c0 + 4),
                    wc0 = *(const f32x4*)(conv_w + 2048 + c0), wc1 = *(const f32x4*)(conv_w + 2048 + c0 + 4);
        const float m0 = (s0 == 0) ? 0.f : 1.f, m5 = (s0 == SEQ - 4) ? 0.f : 1.f;
        float h[6][8];
#pragma unroll
        for (int i = 0; i < 6; ++i) { const float mk = (i == 0) ? m0 : (i == 5) ? m5 : 1.f;
#pragma unroll
            for (int j = 0; j < 4; ++j) { h[i][2 * j] = bf_lo(cc[i][j]) * bf_lo(cx[i][j]) * mk; h[i][2 * j + 1] = bf_hi(cc[i][j]) * bf_hi(cx[i][j]) * mk; } }
#pragma unroll
        for (int i = 0; i < 4; ++i) { float y[8];
#pragma unroll
            for (int j = 0; j < 4; ++j) { y[j] = wa0[j] * h[i][j] + wb0[j] * h[i + 1][j] + wc0[j] * h[i + 2][j]; y[4 + j] = wa1[j] * h[i][4 + j] + wb1[j] * h[i + 1][4 + j] + wc1[j] * h[i + 2][4 + j]; }
            u32x4 o; o.x = cvt_pk_bf16(bf_lo(cb[i].x) * y[0], bf_hi(cb[i].x) * y[1]); o.y = cvt_pk_bf16(bf_lo(cb[i].y) * y[2], bf_hi(cb[i].y) * y[3]);
            o.z = cvt_pk_bf16(bf_lo(cb[i].z) * y[4], bf_hi(cb[i].z) * y[5]); o.w = cvt_pk_bf16(bf_lo(cb[i].w) * y[6], bf_hi(cb[i].w) * y[7]);
            *(u32x4*)(MIXb + (size_t)(t0 + i) * MIXW + c0) = o; }
    }
    const int l16 = lane & 15; const bool first = (l16 & 4) == 0;
    const f32x4 kn0 = *(const f32x4*)(k_norm + l16 * 8), kn1 = *(const f32x4*)(k_norm + l16 * 8 + 4);
    for (int blk = gw; blk < TG / 4; blk += NGW) { const int t0 = blk * 4, s0 = t0 & (SEQ - 1);
        u32x4 kx[4], vx[4]; f32x4 cs[4][4];
#pragma unroll
        for (int i = 0; i < 4; ++i) { kx[i] = *(const u32x4*)(Zb + (size_t)(t0 + i) * DIN + ZC_K + lane * 8); vx[i] = *(const u32x4*)(Zb + (size_t)(t0 + i) * DIN + ZC_V + lane * 8); const int pos = s0 + i;
            const f32x4* tab = (const f32x4*)((l16 < 8) ? (rope_row + (pos >> 6) * 32 + (l16 & 3) * 8) : (rope_col + (pos & 63) * 32 + (l16 & 3) * 8));
#pragma unroll
            for (int j = 0; j < 4; ++j) cs[i][j] = tab[j]; }
#pragma unroll
        for (int i = 0; i < 4; ++i) { float x[8];
#pragma unroll
            for (int j = 0; j < 4; ++j) { x[2 * j] = bf_lo(kx[i][j]); x[2 * j + 1] = bf_hi(kx[i][j]); }
            float ss = 0.f;
#pragma unroll
            for (int j = 0; j < 8; ++j) ss += x[j] * x[j];
            ss += swz_xor<1>(ss); ss += swz_xor<2>(ss); ss += swz_xor<4>(ss); ss += swz_xor<8>(ss);
            const float rstd = 1.0f / sqrtf(ss * (1.0f / 128.0f) + EPS);
            float y[8], o[8];
#pragma unroll
            for (int j = 0; j < 4; ++j) { y[j] = x[j] * rstd * kn0[j]; y[4 + j] = x[4 + j] * rstd * kn1[j]; }
#pragma unroll
            for (int j = 0; j < 8; ++j) { const float py = swz_xor<4>(y[j]); const float c = cs[i][j >> 1][(j & 1) * 2], s = cs[i][j >> 1][(j & 1) * 2 + 1];
                o[j] = first ? (y[j] * c - py * s) : (y[j] * c + py * s); }
            u32x4 ow; ow.x = cvt_pk_bf16(o[0], o[1]); ow.y = cvt_pk_bf16(o[2], o[3]); ow.z = cvt_pk_bf16(o[4], o[5]); ow.w = cvt_pk_bf16(o[6], o[7]);
            const int t = t0 + i, bb = t >> 13, sp = t & (SEQ - 1), r = sp & 63; const size_t img = (size_t)((bb * NKV + (lane >> 4)) * 128 + (sp >> 6)) * 16384;
            const int rk = (r & 32) | att::krow(r & 31);
            *(u32x4*)(KT + img + KSWZ(rk, l16 * 16)) = ow;
            *(u32x4*)(VT + img + att::v_st(r, l16 * 8)) = vx[i]; }
    }
}

__device__ __forceinline__ void phase_attention(int layer, LAS unsigned char* lds) {
    KArgs a = kargs(); unsigned char* ws = ARG(ws); const bf16_t* Zb = (const bf16_t*)(ws + WS_Z); bf16_t* MIXb = (bf16_t*)(ws + WS_MIX);
    const f32x2* rope_row = (const f32x2*)(ws + WS_ROPE); const f32x2* rope_col = rope_row + 128 * 32; const float* qn = ARG(q_norm) + layer * 128;
    const char* KT = (const char*)(ws + WS_KT); const char* VT = (const char*)(ws + WS_VT);
    bool maxfree;
    { const int lane = opaque_tid() & 63; const float* kn = ARG(k_norm) + layer * 128;
      float gq = fmaxf(fabsf(qn[lane]), fabsf(qn[lane + 64])), gk = fmaxf(fabsf(kn[lane]), fabsf(kn[lane + 64]));
      gq = fmaxf(gq, swz_xor<1>(gq)); gq = fmaxf(gq, swz_xor<2>(gq)); gq = fmaxf(gq, swz_xor<4>(gq)); gq = fmaxf(gq, swz_xor<8>(gq)); gq = fmaxf(gq, swz_xor<16>(gq));
      gk = fmaxf(gk, swz_xor<1>(gk)); gk = fmaxf(gk, swz_xor<2>(gk)); gk = fmaxf(gk, swz_xor<4>(gk)); gk = fmaxf(gk, swz_xor<8>(gk)); gk = fmaxf(gk, swz_xor<16>(gk));
      { auto r = __builtin_amdgcn_permlane32_swap(__float_as_uint(gq), __float_as_uint(gq), false, false); gq = fmaxf(__uint_as_float(r[0]), __uint_as_float(r[1])); }
      { auto r = __builtin_amdgcn_permlane32_swap(__float_as_uint(gk), __float_as_uint(gk), false, false); gk = fmaxf(__uint_as_float(r[0]), __uint_as_float(r[1])); }
      const float bound = att::SCALE * 1.4426950408889634f * 128.0f * gq * gk;
      maxfree = __builtin_amdgcn_readfirstlane(bound < 100.0f ? 1 : 0) != 0; }
    for (int u = blockIdx.x; u < 1024; u += gridDim.x) { const int i = u >> 8, cc = u & 255, pair = cc & 7, qb = cc >> 3, b = pair >> 2, kvh = pair & 3, h = kvh * 4 + i;
        const size_t img = (size_t)((b * NKV + kvh) * 128) * 16384;
        if (maxfree) att::attn_body_maxfree(Zb + ((size_t)b * SEQ + (size_t)qb * 256) * DIN + ZC_Q + h * HD, KT + img, VT + img,
                                 MIXb + ((size_t)b * SEQ + (size_t)qb * 256) * MIXW + 2048 + h * HD, SEQ / 64, lds, qn, rope_row, rope_col, qb * 256);
        else att::attn_dense_body_dma(Zb + ((size_t)b * SEQ + (size_t)qb * 256) * DIN + ZC_Q + h * HD, KT + img, VT + img,
                                 MIXb + ((size_t)b * SEQ + (size_t)qb * 256) * MIXW + 2048 + h * HD, SEQ / 64, lds, qn, rope_row, rope_col, qb * 256);
        asm volatile("s_waitcnt lgkmcnt(0)" ::: "memory"); __builtin_amdgcn_s_barrier(); asm volatile("" ::: "memory"); }
}

#ifndef PH_MASK
#define PH_MASK 0xFFFF
#endif
#define PH(n) constexpr ((PH_MASK >> (n)) & 1)
#ifndef REP_MASK
#define REP_MASK 0
#endif
#define REP(n) constexpr ((REP_MASK >> (n)) & 1)

__global__ void __launch_bounds__(512, 2) fwd_kernel(Args a_unused) {
    extern __shared__ __attribute__((aligned(16))) unsigned char lds_raw[];
    LAS unsigned char* lds = (LAS unsigned char*)lds_raw;
    for (int u = threadIdx.x; u < (LDS_BYTES - LDSCTL_OFF) / 4; u += 512) ((LAS unsigned*)(lds + LDSCTL_OFF))[u] = 0u;
    __syncthreads();
    XcdBarrier bar = xcd_barrier_post((unsigned*)(((unsigned char*)kargs()->ws) + WS_CTL), (volatile LAS unsigned*)(lds + LDSCTL_OFF + 64));

    if PH(0) phase_prologue(lds);
    xcd_barrier(bar);

    for (int j = -1; j < DEPTH * NGRP; ++j) {
        const bool old_ok = j >= 0, new_ok = j + 1 < DEPTH * NGRP;
        const int jo = old_ok ? j : 0, jn = new_ok ? j + 1 : 0;
        const int lo = jo / NGRP, go = jo - lo * NGRP, layer = jn / NGRP, grp = jn - layer * NGRP;
        if (old_ok) { if PH(6) { KArgs a = kargs(); unsigned char* ws = ARG(ws);
                pg8::EpiResidSS E{(const bf16_t*)(ws + WS_XBA) + (size_t)go * TG * DM, (bf16_t*)(ws + WS_H), (unsigned*)(ws + WS_SS) + (size_t)3 * TG};
                pg8::gemm_phase<pg8::EpiResidSS, TG, DM, DM>(lds, (const bf16_t*)(ws + WS_MRG), (const bf16_t*)(ws + WS_WOUT) + (size_t)lo * DM * DM, gridDim.x, blockIdx.x, E); }
            __syncthreads(); }
        if (new_ok) { if PH(2) { KArgs a = kargs(); unsigned char* ws = ARG(ws); pg8::EpiBf16 E{(bf16_t*)(ws + WS_Z), DIN, (const unsigned*)(ws + WS_SS) + (size_t)grp * TG};
                pg8::gemm_phase<pg8::EpiBf16, TG, DIN, DM>(lds, (const bf16_t*)(ws + WS_XBA) + (size_t)grp * TG * DM, (const bf16_t*)(ws + WS_WIN) + (size_t)layer * DIN * DM, gridDim.x, blockIdx.x, E); } }
        xcd_barrier(bar);
        if (old_ok) { if PH(8) { KArgs a = kargs(); unsigned char* ws = ARG(ws); pg8::EpiSwiGLU E{(bf16_t*)(ws + WS_ACT), DFF, (const unsigned*)(ws + WS_SS) + (size_t)3 * TG};
                pg8::gemm_phase<pg8::EpiSwiGLU, TG, NFF2, DM>(lds, (const bf16_t*)(ws + WS_H), (const bf16_t*)(ws + WS_WFI) + (size_t)lo * NFF2 * DM, gridDim.x, blockIdx.x, E); }
            __syncthreads(); }
        if (new_ok) { if PH(3) { phase_sgu(layer, lds); phase_conv_k(layer, grp); } }
        xcd_barrier(bar);
        if (old_ok) { if PH(9) { KArgs a = kargs(); unsigned char* ws = ARG(ws);
                pg8::EpiResidSS E{(const bf16_t*)(ws + WS_H), (bf16_t*)(ws + WS_XBA) + (size_t)go * TG * DM, (unsigned*)(ws + WS_SS) + (size_t)go * TG};
                pg8::gemm_phase<pg8::EpiResidSS, TG, DM, DFF>(lds, (const bf16_t*)(ws + WS_ACT), (const bf16_t*)(ws + WS_WFO) + (size_t)lo * DM * DFF, gridDim.x, blockIdx.x, E); }
            __syncthreads(); }
        if (new_ok) { if PH(4) { { KArgs a = kargs(); unsigned* SS3 = (unsigned*)(ARG(ws) + WS_SS) + (size_t)3 * TG; const int tid = opaque_tid();
                  for (int i = blockIdx.x * 512 + tid; i < TG; i += gridDim.x * 512) __hip_atomic_store(SS3 + i, 0u, __ATOMIC_RELAXED, __HIP_MEMORY_SCOPE_AGENT); }
                phase_attention(layer, lds); } }
        xcd_barrier(bar);
        if (new_ok) { if PH(5) { KArgs a = kargs(); unsigned char* ws = ARG(ws); pg8::EpiMerge E{(const bf16_t*)(ws + WS_Z) + ZC_G, ARG(gate_bias) + (size_t)layer * 3 * DM, (bf16_t*)(ws + WS_MRG)};
                pg8::gemm_phase<pg8::EpiMerge, TG, DM, MIXW>(lds, (const bf16_t*)(ws + WS_MIX), (const bf16_t*)(ws + WS_WBR) + (size_t)layer * DM * MIXW, gridDim.x, blockIdx.x, E); }
            xcd_barrier(bar); }
    }

    if PH(10) {
        KArgs a = kargs(); const int tid = opaque_tid(), lane = tid & 63, wave = __builtin_amdgcn_readfirstlane(tid >> 6);
        const int gw = blockIdx.x * 8 + wave, NGW = gridDim.x * 8; float* out = ARG(out); const bf16_t* XBA = (const bf16_t*)(ARG(ws) + WS_XBA);
        const f32x4* gr = (const f32x4*)ARG(norm_final) + 2 * lane; f32x4 gv[8];
#pragma unroll
        for (int j = 0; j < 4; ++j) { gv[2 * j] = gr[128 * j]; gv[2 * j + 1] = gr[128 * j + 1]; }
        for (int m = gw; m < NTOK; m += NGW) {
            const u32x4* xr = (const u32x4*)(XBA + (size_t)m * DM) + lane; f32x4 v[8]; float ss = 0.f;
#pragma unroll
            for (int j = 0; j < 4; ++j) { const u32x4 b = xr[64 * j]; v[2 * j] = (f32x4){bf_lo(b.x), bf_hi(b.x), bf_lo(b.y), bf_hi(b.y)}; v[2 * j + 1] = (f32x4){bf_lo(b.z), bf_hi(b.z), bf_lo(b.w), bf_hi(b.w)}; }
#pragma unroll
            for (int j = 0; j < 8; ++j) ss += (v[j].x * v[j].x + v[j].y * v[j].y) + (v[j].z * v[j].z + v[j].w * v[j].w);
            const float rstd = 1.0f / sqrtf(wave_sum(ss) * (1.0f / DM) + EPS);
            f32x4* orow = (f32x4*)(out + (size_t)m * DM) + 2 * lane;
#pragma unroll
            for (int j = 0; j < 4; ++j) { orow[128 * j] = v[2 * j] * rstd * gv[2 * j]; orow[128 * j + 1] = v[2 * j + 1] * rstd * gv[2 * j + 1]; }
        }
    }
}

extern "C" void kernel_launch(void* const* d_in, const int* in_sizes, int n_in, void* d_out, int out_size, void* d_ws, size_t ws_size, hipStream_t stream) {
    static int grid = 0;
    if (grid == 0) {
        if (n_in != 19 || out_size != NTOK * DM || ws_size < WS_END) { fprintf(stderr, "kernel_launch: unexpected shapes: n_in %d out %d ws %zu (need %zu)\n", n_in, out_size, ws_size, (size_t)WS_END); grid = -1; return; }
        int dev = 0, cus = 0, per_cu = 0;
        if (hipGetDevice(&dev) != hipSuccess || hipDeviceGetAttribute(&cus, hipDeviceAttributeMultiprocessorCount, dev) != hipSuccess) { fprintf(stderr, "kernel_launch: device query failed\n"); grid = -1; return; }
        if (hipFuncSetAttribute((const void*)fwd_kernel, hipFuncAttributeMaxDynamicSharedMemorySize, LDS_BYTES) != hipSuccess) { fprintf(stderr, "kernel_launch: hipFuncSetAttribute failed\n"); grid = -1; return; }
        if (hipOccupancyMaxActiveBlocksPerMultiprocessor(&per_cu, (const void*)fwd_kernel, 512, LDS_BYTES) != hipSuccess || per_cu < 1) { fprintf(stderr, "kernel_launch: occupancy query says %d blocks per CU\n", per_cu); }
        (void)hipGetLastError();
        grid = cus;
    }
    if (grid < 0) return;
    if (hipMemsetAsync((char*)d_ws + WS_CTL, 0, CTL_ZERO_BYTES, stream) != hipSuccess) { fprintf(stderr, "kernel_launch: memset failed\n"); return; }
    Args a{};
    a.x_prompt = (const float*)d_in[0]; a.x_sample = (const float*)d_in[1]; a.norm_mix = (const float*)d_in[2]; a.w_in = (const float*)d_in[3]; a.gate_bias = (const float*)d_in[4];
    a.conv_w = (const float*)d_in[5]; a.sgu_ln = (const float*)d_in[6]; a.sgu_ws = (const float*)d_in[7]; a.sgu_b = (const float*)d_in[8]; a.q_norm = (const float*)d_in[9];
    a.k_norm = (const float*)d_in[10]; a.w_br_conv = (const float*)d_in[11]; a.w_br_sgu = (const float*)d_in[12]; a.w_br_attn = (const float*)d_in[13]; a.w_out = (const float*)d_in[14];
    a.norm_ffn = (const float*)d_in[15]; a.w_ffn_in = (const float*)d_in[16]; a.w_ffn_out = (const float*)d_in[17]; a.norm_final = (const float*)d_in[18];
    a.out = (float*)d_out; a.ws = (unsigned char*)d_ws;
    hipLaunchKernelGGL(fwd_kernel, dim3(grid), dim3(512), LDS_BYTES, stream, a);
    const hipError_t le = hipPeekAtLastError();
    if (le != hipSuccess) fprintf(stderr, "kernel_launch: launch failed: %s\n", hipGetErrorName(le));
}
```
